# Optimizing an MI355X kernel written in HIP

```python
import jax, jax.numpy as jnp
from jax import lax
import numpy as np

D_MODEL = 1024
BATCH = 16
SEQ = 4096
DEPTH = 2
DEC_BATCH = 8
DEC_SEQ = 8192
PAST_LEN = 128

GRID_W = 64
N_EVEN = (DEPTH + 1) // 2
N_ODD = DEPTH // 2
D_FF = 2816
EPS = 1e-6
FOURIER_W = D_MODEL // 4
FOURIER_CH = 64
FOURIER_GROUPS = FOURIER_W // FOURIER_CH
HEAD_DIM = 64
ATTN_W = 3 * D_MODEL // 4
N_Q_HEADS = ATTN_W // HEAD_DIM
N_KV_HEADS = 4
Q_PER_KV = N_Q_HEADS // N_KV_HEADS
KV_W = N_KV_HEADS * HEAD_DIM
AB_IN_W = FOURIER_W + ATTN_W + 2 * KV_W
AB_MIX_W = FOURIER_W + ATTN_W
Q_BLOCK = 128
ROPE_THETA = 10000.0
ROPE_HALF = HEAD_DIM // 2
ROPE_FREQS = ROPE_HALF // 2
M_HEADS = 4
M_W = D_MODEL
M_HEAD_DIM = M_W // M_HEADS
M_CONV = 3
M_CHUNK = 64
M_IN_W = 4 * M_W + 4 * M_HEADS

kernel_name = "hybrid_fnet_gqa_mlstm_macaron_encoder"


def rmsnorm(x, g):
    xf = x.astype(jnp.float32)
    y = xf * lax.rsqrt(jnp.mean(xf * xf, axis=-1, keepdims=True) + EPS)
    return (y * g.astype(jnp.float32)).astype(x.dtype)


def swiglu(x, w_in, w_out):
    gate, up = jnp.split(x @ w_in, 2, axis=-1)
    return (jax.nn.silu(gate) * up) @ w_out


def axial_rope_tables(n_tok):
    rows = n_tok // GRID_W
    row_id = jnp.repeat(jnp.arange(rows, dtype=jnp.float32), GRID_W)
    col_id = jnp.tile(jnp.arange(GRID_W, dtype=jnp.float32), rows)
    freqs = ROPE_THETA ** (-jnp.arange(ROPE_FREQS, dtype=jnp.float32) / ROPE_FREQS)
    ang_r = row_id[:, None] * freqs[None, :]
    ang_c = col_id[:, None] * freqs[None, :]
    return jnp.cos(ang_r), jnp.sin(ang_r), jnp.cos(ang_c), jnp.sin(ang_c)


def _rotate(xh, c, s):
    x1, x2 = jnp.split(xh, 2, axis=-1)
    c = c[None, :, None, :]
    s = s[None, :, None, :]
    return jnp.concatenate([x1 * c - x2 * s, x1 * s + x2 * c], axis=-1)


def apply_axial_rope(x, tables):
    cr, sr, cc, sc = tables
    xf = x.astype(jnp.float32)
    xr, xc = jnp.split(xf, 2, axis=-1)
    return jnp.concatenate([_rotate(xr, cr, sr), _rotate(xc, cc, sc)], axis=-1).astype(x.dtype)


def gqa_bidirectional(q, k, v):
    B, S = q.shape[0], q.shape[1]
    nblk = S // Q_BLOCK
    qg = q.reshape(B, nblk, Q_BLOCK, N_KV_HEADS, Q_PER_KV, HEAD_DIM).transpose(1, 0, 2, 3, 4, 5)
    scale = HEAD_DIM ** -0.5

    def block(qb):
        s = jnp.einsum('bqhgd,bkhd->bhgqk', qb, k, preferred_element_type=jnp.float32) * scale
        p = jax.nn.softmax(s, axis=-1)
        return jnp.einsum('bhgqk,bkhd->bqhgd', p.astype(v.dtype), v)

    o = lax.map(block, qg)
    return o.transpose(1, 0, 2, 3, 4, 5).reshape(B, S, ATTN_W)


def fourier_gqa_mixer(u, w_in, q_norm, k_norm, w_out):
    B, S, _ = u.shape
    z = u @ w_in
    f, q, k, v = jnp.split(z, [FOURIER_W, FOURIER_W + ATTN_W, FOURIER_W + ATTN_W + KV_W], axis=-1)
    fg = f.reshape(B, S, FOURIER_GROUPS, FOURIER_CH).astype(jnp.float32)
    f_mix = jnp.fft.fft2(fg, axes=(1, 3), norm='ortho').real.reshape(B, S, FOURIER_W).astype(u.dtype)
    q = rmsnorm(q.reshape(B, S, N_Q_HEADS, HEAD_DIM), q_norm)
    k = rmsnorm(k.reshape(B, S, N_KV_HEADS, HEAD_DIM), k_norm)
    v = v.reshape(B, S, N_KV_HEADS, HEAD_DIM)
    tables = axial_rope_tables(S)
    q = apply_axial_rope(q, tables)
    k = apply_axial_rope(k, tables)
    a = gqa_bidirectional(q, k, v)
    return jnp.concatenate([f_mix, a], axis=-1) @ w_out


def centred_conv(x, w):
    S = x.shape[1]
    pad = M_CONV // 2
    xp = jnp.pad(x, ((0, 0), (pad, pad), (0, 0)))
    return sum(xp[:, j:j + S] * w[j] for j in range(M_CONV))


def mlstm_chunkwise(q, k, v, ig, lf):
    B, H, S, d = q.shape
    nC = S // M_CHUNK

    def chunks(a):
        return jnp.moveaxis(a.reshape(a.shape[:2] + (nC, M_CHUNK) + a.shape[3:]), 2, 0)

    tril = jnp.tril(jnp.ones((M_CHUNK, M_CHUNK), dtype=bool))

    def step(carry, xs):
        C, n, m = carry
        qc, kc, vc, ic, fc = xs
        b = jnp.cumsum(fc, axis=-1)
        D = jnp.where(tril, b[..., :, None] - b[..., None, :] + ic[..., None, :], -jnp.inf)
        inter = b + m[..., None]
        mj = jnp.maximum(inter, jnp.max(D, axis=-1))
        w_inter = jnp.exp(inter - mj)
        P = jnp.exp(D - mj[..., None])
        sqk = jnp.einsum('bhjd,bhsd->bhjs', qc, kc) * P
        num = (w_inter[..., None] * jnp.einsum('bhed,bhjd->bhje', C, qc)
               + jnp.einsum('bhjs,bhse->bhje', sqk, vc))
        den = w_inter * jnp.einsum('bhd,bhjd->bhj', n, qc) + jnp.sum(sqk, axis=-1)
        h = num / jnp.maximum(jnp.abs(den), jnp.exp(-mj))[..., None]
        bL = b[..., -1]
        gs = bL[..., None] - b + ic
        m_new = jnp.maximum(bL + m, jnp.max(gs, axis=-1))
        decay = jnp.exp(bL + m - m_new)
        ws = jnp.exp(gs - m_new[..., None])
        C = decay[..., None, None] * C + jnp.einsum('bhse,bhsd->bhed', vc * ws[..., None], kc)
        n = decay[..., None] * n + jnp.einsum('bhs,bhsd->bhd', ws, kc)
        return (C, n, m_new), h

    init = (jnp.zeros((B, H, d, d), jnp.float32), jnp.zeros((B, H, d), jnp.float32),
            jnp.zeros((B, H), jnp.float32))
    _, hs = lax.scan(step, init, (chunks(q), chunks(k), chunks(v), chunks(ig), chunks(lf)))
    return jnp.moveaxis(hs, 0, 2).reshape(B, H, S, d)


def mlstm_mixer(u, w_in, gate_bias, conv_w, head_norm, w_out):
    B, S, _ = u.shape
    z = u @ w_in
    qk, v, o, g = jnp.split(z, [2 * M_W, 3 * M_W, 4 * M_W], axis=-1)
    qk = jax.nn.silu(centred_conv(qk, conv_w))
    q, k = jnp.split(qk, 2, axis=-1)
    g = g.astype(jnp.float32) + gate_bias.astype(jnp.float32)
    i_f, f_f, i_b, f_b = jnp.split(g, 4, axis=-1)

    def heads(a):
        return a.reshape(B, S, M_HEADS, M_HEAD_DIM).transpose(0, 2, 1, 3).astype(jnp.float32)

    qh = heads(q)
    kh = heads(k) * (M_HEAD_DIM ** -0.5)
    vh = heads(v)
    tg = lambda a: a.transpose(0, 2, 1)
    h_f = mlstm_chunkwise(qh, kh, vh, tg(i_f), jax.nn.log_sigmoid(tg(f_f)))
    flip = lambda a: jnp.flip(a, axis=2)
    h_b = flip(mlstm_chunkwise(flip(qh), flip(kh), flip(vh), flip(tg(i_b)),
                               flip(jax.nn.log_sigmoid(tg(f_b)))))
    h = (h_f + h_b).transpose(0, 2, 1, 3).astype(u.dtype)
    h = rmsnorm(h, head_norm.reshape(M_HEADS, M_HEAD_DIM)).reshape(B, S, M_W)
    return (jax.nn.sigmoid(o) * h) @ w_out


def trunk(x, ffn1_norm, ffn1_w_in, ffn1_w_out, mix_norm, ab_w_in, ab_q_norm, ab_k_norm, ab_w_out,
          c_w_in, c_gate_bias, c_conv, c_head_norm, c_w_out, ffn2_norm, ffn2_w_in, ffn2_w_out):
    for l in range(DEPTH):
        x = x + 0.5 * swiglu(rmsnorm(x, ffn1_norm[l]), ffn1_w_in[l], ffn1_w_out[l])
        u = rmsnorm(x, mix_norm[l])
        if l % 2 == 0:
            j = l // 2
            x = x + fourier_gqa_mixer(u, ab_w_in[j], ab_q_norm[j], ab_k_norm[j], ab_w_out[j])
        else:
            j = l // 2
            x = x + mlstm_mixer(u, c_w_in[j], c_gate_bias[j], c_conv[j], c_head_norm[j], c_w_out[j])
        x = x + 0.5 * swiglu(rmsnorm(x, ffn2_norm[l]), ffn2_w_in[l], ffn2_w_out[l])
    return x


def setup_inputs(seed: int = 0) -> dict:
    key = jax.random.key(seed)
    ks = jax.random.split(key, 24)
    f32 = jnp.float32
    nrm = lambda k, shape, scale: jax.random.normal(k, shape, f32) * scale
    gain = lambda k, shape: 1.0 + 0.02 * jax.random.normal(k, shape, f32)
    f_bias = jnp.linspace(3.0, 6.0, M_HEADS, dtype=f32)
    gb_noise = nrm(ks[22], (N_ODD, 4, M_HEADS), 0.1)
    gate_bias = (gb_noise + jnp.stack([jnp.zeros_like(f_bias), f_bias,
                                      jnp.zeros_like(f_bias), f_bias])[None]).reshape(N_ODD, 4 * M_HEADS)
    return {
        "x_prompt": jax.random.normal(ks[0], (BATCH, SEQ, D_MODEL), f32),
        "x_sample": jax.random.normal(ks[1], (DEC_BATCH, DEC_SEQ, D_MODEL), f32),
        "ffn1_norm": gain(ks[2], (DEPTH, D_MODEL)),
        "ffn1_w_in": nrm(ks[3], (DEPTH, D_MODEL, 2 * D_FF), D_MODEL ** -0.5),
        "ffn1_w_out": nrm(ks[4], (DEPTH, D_FF, D_MODEL), D_FF ** -0.5),
        "mix_norm": gain(ks[5], (DEPTH, D_MODEL)),
        "ab_w_in": nrm(ks[6], (N_EVEN, D_MODEL, AB_IN_W), D_MODEL ** -0.5),
        "ab_q_norm": gain(ks[7], (N_EVEN, HEAD_DIM)),
        "ab_k_norm": gain(ks[8], (N_EVEN, HEAD_DIM)),
        "ab_w_out": nrm(ks[9], (N_EVEN, AB_MIX_W, D_MODEL), AB_MIX_W ** -0.5),
        "c_w_in": nrm(ks[10], (N_ODD, D_MODEL, M_IN_W), D_MODEL ** -0.5),
        "c_gate_bias": gate_bias,
        "c_conv": nrm(ks[11], (N_ODD, M_CONV, 2 * M_W), M_CONV ** -0.5),
        "c_head_norm": gain(ks[12], (N_ODD, M_W)),
        "c_w_out": nrm(ks[13], (N_ODD, M_W, D_MODEL), M_W ** -0.5),
        "ffn2_norm": gain(ks[14], (DEPTH, D_MODEL)),
        "ffn2_w_in": nrm(ks[15], (DEPTH, D_MODEL, 2 * D_FF), D_MODEL ** -0.5),
        "ffn2_w_out": nrm(ks[16], (DEPTH, D_FF, D_MODEL), D_FF ** -0.5),
    }


def reference(x_prompt, x_sample, ffn1_norm, ffn1_w_in, ffn1_w_out, mix_norm, ab_w_in, ab_q_norm,
              ab_k_norm, ab_w_out, c_w_in, c_gate_bias, c_conv, c_head_norm, c_w_out,
              ffn2_norm, ffn2_w_in, ffn2_w_out):
    y_prompt = trunk(x_prompt, ffn1_norm, ffn1_w_in, ffn1_w_out, mix_norm, ab_w_in, ab_q_norm,
                     ab_k_norm, ab_w_out, c_w_in, c_gate_bias, c_conv, c_head_norm, c_w_out,
                     ffn2_norm, ffn2_w_in, ffn2_w_out)
    y_sample = trunk(x_sample, ffn1_norm, ffn1_w_in, ffn1_w_out, mix_norm, ab_w_in, ab_q_norm,
                     ab_k_norm, ab_w_out, c_w_in, c_gate_bias, c_conv, c_head_norm, c_w_out,
                     ffn2_norm, ffn2_w_in, ffn2_w_out)
    return (y_prompt, y_sample)
```

```cpp
#include <hip/hip_runtime.h>
#include <hip/hip_cooperative_groups.h>
#include <cstdio>
#include <cstdint>
namespace cg = cooperative_groups;

typedef unsigned short bf16_t;
typedef short bf16x8 __attribute__((ext_vector_type(8)));
typedef short s16x4 __attribute__((ext_vector_type(4)));
typedef float f32x16 __attribute__((ext_vector_type(16)));
typedef float f32x4 __attribute__((ext_vector_type(4)));
#define DI __device__ __forceinline__
#define MFMA32(a, b, c) __builtin_amdgcn_mfma_f32_32x32x16_bf16((a), (b), (c), 0, 0, 0)

constexpr int D = 1024, DFF = 2816;
constexpr int MTOK = 131072;
constexpr int MP = 65536;
constexpr float EPS = 1e-6f;
constexpr int ZW = 2048;
constexpr int ABN = 1792;
constexpr int CN = 4352;

constexpr size_t MiB = 1024 * 1024;
constexpr size_t SZ_WIN = (size_t)2 * DFF * D * 2, SZ_WOUT = (size_t)D * DFF * 2;
constexpr size_t WS_FFN_WIN = 0;
constexpr size_t WS_FFN_WOUT = WS_FFN_WIN + 4 * SZ_WIN;
constexpr size_t WS_AB_IN = WS_FFN_WOUT + 4 * SZ_WOUT;
constexpr size_t WS_AB_OUT = WS_AB_IN + (size_t)ABN * D * 2;
constexpr size_t WS_C_IN = WS_AB_OUT + (size_t)D * D * 2;
constexpr size_t WS_C_OUT = WS_C_IN + (size_t)CN * D * 2;
constexpr size_t WS_W_END = WS_C_OUT + (size_t)D * D * 2;
static_assert(WS_W_END <= 84 * MiB, "weights");
constexpr size_t WS_GATES = 92 * MiB;
constexpr size_t WS_SSQ = 84 * MiB;
constexpr size_t WS_ROPE = 94 * MiB;
constexpr size_t WS_W1_64 = WS_ROPE + 65536;
constexpr size_t WS_W1_128 = WS_W1_64 + 32768;
constexpr size_t WS_W2_64 = WS_W1_128 + 131072;
constexpr size_t WS_BAR = 95 * MiB;
constexpr size_t WS_XB = 96 * MiB;
constexpr size_t WS_BIG = 352 * MiB;

constexpr int SMEM_BYTES = 4 * 128 * 72 * 2 + 1024;
constexpr int LDS_BYTES = 2 * SMEM_BYTES + 256;
constexpr int GTOK = 32768;

struct Params {
    const float* x_in[2];
    const float *ffn1_norm, *ffn1_w_in, *ffn1_w_out, *mix_norm, *ab_w_in, *ab_q_norm, *ab_k_norm, *ab_w_out;
    const float *c_w_in, *c_gate_bias, *c_conv, *c_head_norm, *c_w_out, *ffn2_norm, *ffn2_w_in, *ffn2_w_out;
    float* out;
    unsigned char* ws;
};

DI int launder(int x) { asm volatile("" : "+v"(x)); return x; }
#define DOT2(a, b, c) __builtin_amdgcn_fdot2_f32_bf16(__builtin_bit_cast(bf2_t, (unsigned)(a)), __builtin_bit_cast(bf2_t, (unsigned)(b)), (c), false)
DI float bperm(float v, int srclane) { return __int_as_float(__builtin_amdgcn_ds_bpermute(srclane << 2, __float_as_int(v))); }
DI float dpp_xor1(float v) { return __int_as_float(__builtin_amdgcn_update_dpp(0, __float_as_int(v), 0xB1, 0xf, 0xf, false)); }
DI float dpp_xor2(float v) { return __int_as_float(__builtin_amdgcn_update_dpp(0, __float_as_int(v), 0x4E, 0xf, 0xf, false)); }
DI float rdlane(float v, int l) { return __int_as_float(__builtin_amdgcn_readlane(__float_as_int(v), l)); }
DI int lane_id() { int l; asm volatile("v_mbcnt_lo_u32_b32 %0, -1, 0\n\tv_mbcnt_hi_u32_b32 %0, -1, %0" : "=v"(l)); return l; }
DI float xshfl(float v, int m) { const int l = launder(lane_id()); return bperm(v, l ^ m); }
DI float bf2f(bf16_t v) { return __uint_as_float(((unsigned)v) << 16); }
typedef __bf16 bf2_t __attribute__((ext_vector_type(2)));
typedef float f32x2 __attribute__((ext_vector_type(2)));
typedef unsigned u32x4 __attribute__((ext_vector_type(4)));
typedef unsigned u32x2 __attribute__((ext_vector_type(2)));
DI unsigned pack2(float lo, float hi) { f32x2 v = {lo, hi}; return __builtin_bit_cast(unsigned, __builtin_convertvector(v, bf2_t)); }
DI bf16_t f2bf(float f) { return (bf16_t)(pack2(f, 0.f) & 0xffffu); }

#define LAS __attribute__((address_space(3)))
struct HB { LAS unsigned* cnt; unsigned ep; int wv; };
#define TID256(hb) ((((hb).wv & 3) << 6) | lane_id())
DI void hb_sync(HB& hb) {
    __builtin_amdgcn_fence(__ATOMIC_RELEASE, "workgroup");
    hb.ep += 4;
    if (lane_id() == 0) __hip_atomic_fetch_add(hb.cnt, 1u, __ATOMIC_RELAXED, __HIP_MEMORY_SCOPE_WORKGROUP);
    while (__hip_atomic_load(hb.cnt, __ATOMIC_RELAXED, __HIP_MEMORY_SCOPE_WORKGROUP) < hb.ep) __builtin_amdgcn_s_sleep(1);
    __builtin_amdgcn_fence(__ATOMIC_ACQUIRE, "workgroup");
}
template <int MODE>
DI void prep_transpose(const float* __restrict__ W, const float* __restrict__ g, bf16_t* __restrict__ dst, int K, int Nsrc, int nOB, char* smem, int vb, int vg, HB& hb) {
    float* tile = (float*)smem;
    const int nKB = K >> 6, total = nKB * nOB, tid = launder(TID256(hb));
    for (int u = vb; u < total; u += vg) {
        const int kb = u % nKB, ob = u / nKB;
        int srccol;
        if (MODE == 0) srccol = ob * 64;
        else if (MODE == 1) srccol = ((ob & 2) ? DFF : 0) + (ob >> 2) * 128 + (ob & 1) * 64;
        else { if (ob >= 12 && ob < 20) continue; srccol = ob < 12 ? 256 + ob * 64 : 1024 + (ob - 20) * 64; }
        const int c = tid & 63, r0 = tid >> 6;
        hb_sync(hb);
#pragma unroll
        for (int i = 0; i < 16; ++i) {
            const int k = r0 + 4 * i, kk = kb * 64 + k;
            float v = (srccol + c < Nsrc) ? W[(size_t)kk * Nsrc + srccol + c] : 0.f;
            if (g) v *= g[kk];
            tile[k * 65 + c] = v;
        }
        hb_sync(hb);
        const int n = tid >> 2, k0 = (tid & 3) * 16;
        unsigned o[8];
#pragma unroll
        for (int j = 0; j < 8; ++j) o[j] = pack2(tile[(k0 + 2 * j) * 65 + n], tile[(k0 + 2 * j + 1) * 65 + n]);
        uint4* dp = (uint4*)(dst + (size_t)(ob * 64 + n) * K + kb * 64 + k0);
        dp[0] = make_uint4(o[0], o[1], o[2], o[3]);
        dp[1] = make_uint4(o[4], o[5], o[6], o[7]);
    }
}

DI void prep_fourier_w(const float* __restrict__ W  , const float* __restrict__ gam, bf16_t* __restrict__ dst, char* smem, int vb, int vg, HB& hb) {
    float* tile = (float*)smem;
    float* ct = tile + 64 * 65;
    float* st = ct + 64;
    const int tid = launder(TID256(hb));
    for (int u = vb; u < 16 * 4; u += vg) {
        const int kb = u & 15, g = u >> 4;
        hb_sync(hb);
        if (tid < 64) { float s, c; sincospif((float)tid / 32.0f, &s, &c); ct[tid] = c * 0.125f; st[tid] = -s * 0.125f; }
        const int c = tid & 63, r0 = tid >> 6;
#pragma unroll
        for (int i = 0; i < 16; ++i) { const int k = r0 + 4 * i, kk = kb * 64 + k; tile[k * 65 + c] = W[(size_t)kk * 1536 + g * 64 + c] * gam[kk]; }
        hb_sync(hb);
        const int cp = tid >> 2, k0 = (tid & 3) * 16;
        float a[16], b[16];
#pragma unroll
        for (int j = 0; j < 16; ++j) { a[j] = 0.f; b[j] = 0.f; }
        for (int cc = 0; cc < 64; ++cc) {
            const int ph = (cc * cp) & 63; const float cv = ct[ph], sv = st[ph];
#pragma unroll
            for (int j = 0; j < 16; ++j) { const float w = tile[(k0 + j) * 65 + cc]; a[j] += w * cv; b[j] += w * sv; }
        }
        unsigned oa[8], ob[8];
#pragma unroll
        for (int j = 0; j < 8; ++j) { oa[j] = pack2(a[2 * j], a[2 * j + 1]); ob[j] = pack2(b[2 * j], b[2 * j + 1]); }
        uint4* pa = (uint4*)(dst + (size_t)(768 + g * 64 + cp) * 1024 + kb * 64 + k0);
        uint4* pb = (uint4*)(dst + (size_t)(1024 + g * 64 + cp) * 1024 + kb * 64 + k0);
        pa[0] = make_uint4(oa[0], oa[1], oa[2], oa[3]); pa[1] = make_uint4(oa[4], oa[5], oa[6], oa[7]);
        pb[0] = make_uint4(ob[0], ob[1], ob[2], ob[3]); pb[1] = make_uint4(ob[4], ob[5], ob[6], ob[7]);
    }
}


DI int acc_row(int i, int lh) { return (i & 3) + 8 * (i >> 2) + 4 * lh; }

namespace pg8 {
#define PG8_LAS __attribute__((address_space(3)))
constexpr int BM = 256, BK = 64, HALF = 128, HTB = HALF * BK * 2, STAGE_BYTES = 8 * HTB, NXCD = 8, WGM = 8;
__host__ __device__ __forceinline__ int lds_byte(int r, int c) { const int st = (r >> 4) * 2 + (c >> 5), rr = r & 15, cc = c & 31, ob = rr * 64 + cc * 2; return st * 1024 + (ob ^ (((ob >> 9) & 1) << 5)); }
__host__ __device__ __forceinline__ void stage_rc(int b, int& R, int& C) { const int st = b / 1024, sb = b % 1024, swz = sb ^ (((sb >> 9) & 1) << 5); R = (st >> 1) * 16 + swz / 64; C = (st & 1) * 32 + (swz % 64) / 2; }
__host__ __device__ __forceinline__ int perm32(int rho) { const int n = rho >> 4, i = rho & 15; return 8 * (i >> 2) + 4 * n + (i & 3); }
struct Unit { int pm, pn; };
struct Gemm { const bf16_t* A; const bf16_t* Bt; int M, N, K, lda; };
struct StaticOrder {
    int nM, nN, nwg, G, c;
    __host__ __device__ void init(int M, int N, int G_, int c_) { nM = M / BM; nN = N / BM; nwg = nM * nN; G = G_; c = c_; }
    __host__ __device__ bool next(int i, Unit& u) const {
        const long L = (long)i * G + c; if (L >= nwg) return false;
        int wgid = (int)L; { const int q = nwg / NXCD, r = nwg % NXCD, xcd = wgid % NXCD, off = wgid / NXCD; wgid = (xcd < r ? xcd * (q + 1) : r * (q + 1) + (xcd - r) * q) + off; }
        const int nig = WGM * nN, gid = wgid / nig, fm = gid * WGM, gsz = (nM - fm) < WGM ? (nM - fm) : WGM;
        u.pm = fm + ((wgid % nig) % gsz); u.pn = (wgid % nig) / gsz; return true;
    }
    __device__ __forceinline__ void a_ready(const Unit&) const {}
    __device__ __forceinline__ void done(const Unit&) const {}
};
template <class Epi, class Sched, bool ALIGN_EPI = false, bool SP2 = false>
__device__ __forceinline__ void gemm_phase(PG8_LAS unsigned char* lds, const Gemm g, const Sched& S, const Epi& E, int wv8) {
    const int tid = launder((wv8 << 6) | lane_id()), wid = __builtin_amdgcn_readfirstlane(tid >> 6), lane = tid & 63, wr = wid >> 2, wc = wid & 3, fr = lane & 15, fq = lane >> 4;
    const int K = g.K, nt = K / BK;
    unsigned voffA[2], voffB[2];
#pragma unroll
    for (int i = 0; i < 2; ++i) { int R, C; stage_rc(tid * 16 + i * 8192, R, C); const int Rb = Epi::PERM ? ((R & ~31) + perm32(R & 31)) : R;
        voffA[i] = (unsigned)(R * g.lda + C) * 2u; voffB[i] = (unsigned)(Rb * K + C) * 2u; }
    const size_t kstep = (size_t)(BK * 2);
    const size_t hstepA = (size_t)HALF * g.lda * 2, hstepB = (size_t)HALF * K * 2;
    const size_t tstepA = 2 * hstepA, tstepB = 2 * hstepB;
    const unsigned ldsw = (unsigned)wid * 1024u;
    const int aoff = lds_byte(wr * 64 + fr, fq * 8), boff = lds_byte(wc * 32 + fr, fq * 8);
#define PG8_SA(b, h) (((b) * 2 + (h)) * HTB)
#define PG8_SB(b, h) ((4 + (b) * 2 + (h)) * HTB)
#define PG8_STAGE(bufoff, gbase, voff) do { _Pragma("unroll") for (int _i = 0; _i < 2; ++_i) \
        __builtin_amdgcn_global_load_lds((const unsigned*)((const char*)(gbase) + (voff)[_i]), (PG8_LAS unsigned*)(lds + (bufoff) + ldsw + _i * 8192), 16, 0, 0); } while (0)
#define PG8_LDA(dst, b, h) do { _Pragma("unroll") for (int m = 0; m < 4; ++m) _Pragma("unroll") for (int k = 0; k < 2; ++k) dst[m][k] = *(const PG8_LAS bf16x8*)(lds + PG8_SA(b, h) + aoff + m * 2048 + k * 1024); } while (0)
#define PG8_LDB(dst, b, h) do { _Pragma("unroll") for (int n = 0; n < 2; ++n) _Pragma("unroll") for (int k = 0; k < 2; ++k) dst[n][k] = *(const PG8_LAS bf16x8*)(lds + PG8_SB(b, h) + boff + n * 2048 + k * 1024); } while (0)
#define PG8_MMA(ai, bj, At, Bt) do { __builtin_amdgcn_s_setprio(1); _Pragma("unroll") for (int m = 0; m < 4; ++m) _Pragma("unroll") for (int n = 0; n < 2; ++n) _Pragma("unroll") for (int k = 0; k < 2; ++k) \
        acc[ai][bj][m][n] = __builtin_amdgcn_mfma_f32_16x16x32_bf16(Bt[n][k], At[m][k], acc[ai][bj][m][n], 0, 0, 0); __builtin_amdgcn_s_setprio(0); } while (0)
#define PG8_WAIT_V(n) asm volatile("s_waitcnt vmcnt(" #n ")" ::: "memory")
#define PG8_WAIT_L(n) asm volatile("s_waitcnt lgkmcnt(" #n ")" ::: "memory")
#define PG8_BAR __builtin_amdgcn_s_barrier()
#define PG8_SCHED __builtin_amdgcn_sched_barrier(0)
    Unit cur, nxt; int ui = 0;
    if (!S.next(0, cur)) return;
    f32x4 acc[2][2][4][2];
#pragma unroll
    for (int a = 0; a < 2; ++a)
#pragma unroll
        for (int b = 0; b < 2; ++b)
#pragma unroll
            for (int m = 0; m < 4; ++m)
#pragma unroll
                for (int n = 0; n < 2; ++n) acc[a][b][m][n] = (f32x4){0.f, 0.f, 0.f, 0.f};
    bf16x8 At[4][2], B0[2][2], B1[2][2];
    const char* cA = (const char*)g.A + (size_t)cur.pm * tstepA; const char* cB = (const char*)g.Bt + (size_t)cur.pn * tstepB;
    S.a_ready(cur);
    if constexpr (SP2) {
        PG8_STAGE(PG8_SB(0, 0), cB, voffB); PG8_STAGE(PG8_SB(0, 1), cB + hstepB, voffB); PG8_STAGE(PG8_SA(0, 0), cA, voffA); PG8_STAGE(PG8_SA(0, 1), cA + hstepA, voffA);
        if (wr == 1) PG8_BAR;
        PG8_WAIT_V(2); PG8_BAR;
        PG8_STAGE(PG8_SB(1, 0), cB + kstep, voffB); PG8_STAGE(PG8_SA(1, 0), cA + kstep, voffA); PG8_STAGE(PG8_SB(1, 1), cB + hstepB + kstep, voffB);
        PG8_WAIT_V(6); PG8_BAR;
    } else {
        PG8_STAGE(PG8_SB(0, 0), cB, voffB); PG8_STAGE(PG8_SA(0, 0), cA, voffA); PG8_STAGE(PG8_SB(0, 1), cB + hstepB, voffB); PG8_STAGE(PG8_SA(0, 1), cA + hstepA, voffA);
        if (wr == 1) PG8_BAR;
        PG8_WAIT_V(4); PG8_BAR;
        PG8_STAGE(PG8_SB(1, 0), cB + kstep, voffB); PG8_STAGE(PG8_SA(1, 0), cA + kstep, voffA); PG8_STAGE(PG8_SB(1, 1), cB + hstepB + kstep, voffB);
        PG8_WAIT_V(6); PG8_BAR;
    }
    for (;;) {
        const bool has_next = S.next(ui + 1, nxt);
        const char* nA = has_next ? (const char*)g.A + (size_t)nxt.pm * tstepA : cA; const char* nB = has_next ? (const char*)g.Bt + (size_t)nxt.pn * tstepB : cB;
        for (int t = 0; t < nt; t += 2) {
            const bool last = (t == nt - 2);
            const char* a1 = cA + (size_t)(t + 1) * kstep;
            const char* a2 = last ? nA : cA + (size_t)(t + 2) * kstep; const char* b2 = last ? nB : cB + (size_t)(t + 2) * kstep;
            const char* a3 = a2 + kstep; const char* b3 = b2 + kstep;
            if (last && has_next) S.a_ready(nxt);
            if constexpr (SP2) {
            PG8_LDB(B0, 0, 0); PG8_LDB(B1, 0, 1); PG8_SCHED; PG8_LDA(At, 0, 0); PG8_STAGE(PG8_SA(1, 1), a1 + hstepA, voffA);
            PG8_WAIT_V(8); PG8_WAIT_L(0); PG8_BAR; PG8_MMA(0, 0, At, B0); PG8_MMA(0, 1, At, B1); PG8_BAR; PG8_SCHED;
            PG8_LDA(At, 0, 1); PG8_STAGE(PG8_SB(0, 0), b2, voffB); PG8_STAGE(PG8_SB(0, 1), b2 + hstepB, voffB); PG8_STAGE(PG8_SA(0, 0), a2, voffA);
            PG8_WAIT_V(8); PG8_WAIT_L(0); PG8_BAR; PG8_MMA(1, 0, At, B0); PG8_MMA(1, 1, At, B1); PG8_BAR; PG8_SCHED;
            PG8_LDB(B0, 1, 0); PG8_LDB(B1, 1, 1); PG8_SCHED; PG8_LDA(At, 1, 0); PG8_STAGE(PG8_SA(0, 1), a2 + hstepA, voffA);
            PG8_WAIT_V(8); PG8_WAIT_L(0); PG8_BAR; PG8_MMA(0, 0, At, B0); PG8_MMA(0, 1, At, B1); PG8_BAR; PG8_SCHED;
            PG8_LDA(At, 1, 1); PG8_STAGE(PG8_SB(1, 0), b3, voffB); PG8_STAGE(PG8_SB(1, 1), b3 + hstepB, voffB); PG8_STAGE(PG8_SA(1, 0), a3, voffA);
            PG8_WAIT_V(8); PG8_WAIT_L(0); PG8_BAR; PG8_MMA(1, 0, At, B0); PG8_MMA(1, 1, At, B1); PG8_BAR; PG8_SCHED;
            } else {
            PG8_LDB(B0, 0, 0); PG8_SCHED; PG8_LDA(At, 0, 0); PG8_STAGE(PG8_SA(1, 1), a1 + hstepA, voffA);
            PG8_WAIT_L(8); PG8_BAR; PG8_WAIT_L(0); PG8_MMA(0, 0, At, B0); PG8_BAR; PG8_SCHED;
            PG8_LDB(B1, 0, 1); PG8_STAGE(PG8_SB(0, 0), b2, voffB);
            PG8_BAR; PG8_WAIT_L(0); PG8_MMA(0, 1, At, B1); PG8_BAR;
            PG8_LDA(At, 0, 1); PG8_STAGE(PG8_SA(0, 0), a2, voffA);
            PG8_BAR; PG8_WAIT_L(0); PG8_MMA(1, 0, At, B0); PG8_BAR; PG8_SCHED;
            PG8_STAGE(PG8_SB(0, 1), b2 + hstepB, voffB);
            PG8_WAIT_V(6); PG8_BAR; PG8_MMA(1, 1, At, B1); PG8_BAR;
            PG8_LDB(B0, 1, 0); PG8_SCHED; PG8_LDA(At, 1, 0); PG8_STAGE(PG8_SA(0, 1), a2 + hstepA, voffA);
            PG8_WAIT_L(8); PG8_BAR; PG8_WAIT_L(0); PG8_MMA(0, 0, At, B0); PG8_BAR; PG8_SCHED;
            PG8_LDB(B1, 1, 1); PG8_STAGE(PG8_SB(1, 0), b3, voffB);
            PG8_BAR; PG8_WAIT_L(0); PG8_MMA(0, 1, At, B1); PG8_BAR;
            PG8_LDA(At, 1, 1); PG8_STAGE(PG8_SA(1, 0), a3, voffA);
            PG8_BAR; PG8_WAIT_L(0); PG8_MMA(1, 0, At, B0); PG8_BAR; PG8_SCHED;
            PG8_STAGE(PG8_SB(1, 1), b3 + hstepB, voffB);
            PG8_WAIT_V(6); PG8_BAR; PG8_MMA(1, 1, At, B1); PG8_BAR;
            }
        }
        if constexpr (ALIGN_EPI) { if (wr == 0) PG8_BAR; }
        if constexpr (!Epi::AFTER_DRAIN) { E(acc, cur, wr, wc, fr, fq); S.done(cur); }
        if (!has_next) break;
#pragma unroll
        for (int a = 0; a < 2; ++a)
#pragma unroll
            for (int b = 0; b < 2; ++b)
#pragma unroll
                for (int m = 0; m < 4; ++m)
#pragma unroll
                    for (int n = 0; n < 2; ++n) acc[a][b][m][n] = (f32x4){0.f, 0.f, 0.f, 0.f};
        cur = nxt; cA = nA; cB = nB; ++ui;
        if constexpr (ALIGN_EPI) { if (wr == 1) PG8_BAR; }
    }
    PG8_WAIT_V(0);
    if constexpr (!ALIGN_EPI) { if (wr == 0) PG8_BAR; }
    PG8_BAR;
    if constexpr (Epi::AFTER_DRAIN) { E.fused(acc, cur, wr, wc, fr, fq, lds, wid, lane); S.done(cur); }
#undef PG8_SA
#undef PG8_SB
#undef PG8_STAGE
#undef PG8_LDA
#undef PG8_LDB
#undef PG8_MMA
#undef PG8_WAIT_V
#undef PG8_WAIT_L
#undef PG8_BAR
#undef PG8_SCHED
}
}

constexpr int SSQW = 4;
DI float row_rstd(const float* __restrict__ ssq, int row) {
    const float4 a = *(const float4*)(ssq + (size_t)row * SSQW);
    return rsqrtf(((a.x + a.y) + (a.z + a.w)) * (1.0f / 1024.0f) + EPS);
}
struct EpiSwiglu {
    static constexpr bool PERM = true, AFTER_DRAIN = false;
    bf16_t* H; bf16_t* H1; const float* ssq;
    DI void operator()(const f32x4 (&acc)[2][2][4][2], const pg8::Unit& u, int wr, int wc, int fr, int fq) const {
        const int row0 = u.pm * 256 + wr * 64 + fr, col0 = u.pn * 128 + wc * 32 + 8 * fq;
        bf16_t* Hb = (u.pm * 256 < MP) ? H : H1 - (size_t)MP * DFF;
#pragma unroll
        for (int ai = 0; ai < 2; ++ai)
#pragma unroll
            for (int m = 0; m < 4; ++m) {
                const int row = row0 + ai * 128 + m * 16;
                const float r = row_rstd(ssq, row);
                float h[8];
#pragma unroll
                for (int n = 0; n < 2; ++n)
#pragma unroll
                    for (int j = 0; j < 4; ++j) {
                        const float g = acc[ai][0][m][n][j] * r, uu = acc[ai][1][m][n][j] * r;
                        h[4 * n + j] = g * __builtin_amdgcn_rcpf(1.0f + __builtin_amdgcn_exp2f(-1.4426950408889634f * g)) * uu;
                    }
                *(uint4*)(Hb + (size_t)row * DFF + col0) = make_uint4(pack2(h[0], h[1]), pack2(h[2], h[3]), pack2(h[4], h[5]), pack2(h[6], h[7]));
            }
    }
};
struct EpiResid {
    static constexpr bool PERM = true, AFTER_DRAIN = false;
    const float* XR; float* XO; bf16_t* XB; float* ssq; float alpha; LAS float* xs;
    DI void operator()(const f32x4 (&acc)[2][2][4][2], const pg8::Unit& u, int wr, int wc, int fr, int fq) const {
        const int row0 = u.pm * 256 + wr * 64 + fr, col0 = u.pn * 256 + wc * 32 + 8 * fq;
#pragma unroll
        for (int ai = 0; ai < 2; ++ai)
#pragma unroll
            for (int m = 0; m < 4; ++m) {
                const int row = row0 + ai * 128 + m * 16;
                float sq = 0.f;
#pragma unroll
                for (int bj = 0; bj < 2; ++bj) {
                    const size_t idx = (size_t)row * D + col0 + bj * 128;
                    float4 x0, x1;
                    if (XR) { x0 = *(const float4*)(XR + idx); x1 = *(const float4*)(XR + idx + 4); }
                    else {
                        const uint4 xv = *(const uint4*)(XB + idx);
                        x0 = make_float4(__uint_as_float(xv.x << 16), __uint_as_float(xv.x & 0xffff0000u), __uint_as_float(xv.y << 16), __uint_as_float(xv.y & 0xffff0000u));
                        x1 = make_float4(__uint_as_float(xv.z << 16), __uint_as_float(xv.z & 0xffff0000u), __uint_as_float(xv.w << 16), __uint_as_float(xv.w & 0xffff0000u));
                    }
                    float4 y0, y1;
                    y0.x = x0.x + alpha * acc[ai][bj][m][0][0]; y0.y = x0.y + alpha * acc[ai][bj][m][0][1]; y0.z = x0.z + alpha * acc[ai][bj][m][0][2]; y0.w = x0.w + alpha * acc[ai][bj][m][0][3];
                    y1.x = x1.x + alpha * acc[ai][bj][m][1][0]; y1.y = x1.y + alpha * acc[ai][bj][m][1][1]; y1.z = x1.z + alpha * acc[ai][bj][m][1][2]; y1.w = x1.w + alpha * acc[ai][bj][m][1][3];
                    if (XO) { *(float4*)(XO + idx) = y0; *(float4*)(XO + idx + 4) = y1; }
                    else {
                        *(uint4*)(XB + idx) = make_uint4(pack2(y0.x, y0.y), pack2(y0.z, y0.w), pack2(y1.x, y1.y), pack2(y1.z, y1.w));
                        sq += (y0.x * y0.x + y0.y * y0.y) + (y0.z * y0.z + y0.w * y0.w) + (y1.x * y1.x + y1.y * y1.y) + (y1.z * y1.z + y1.w * y1.w);
                    }
                }
                if (!XO) {
                    sq += xshfl(sq, 16); sq += xshfl(sq, 32);
                    if (fq == 0) xs[(ai * 128 + wr * 64 + m * 16 + fr) * 4 + wc] = sq;
                }
            }
        if (!XO) {
            __syncthreads();
            const int t9 = ((wr * 4 + wc) << 6) | (fq << 4) | fr;
            if (t9 < 256) {
                const float v0 = xs[t9 * 4], v1 = xs[t9 * 4 + 1], v2 = xs[t9 * 4 + 2], v3 = xs[t9 * 4 + 3];
                ssq[(size_t)(u.pm * 256 + t9) * SSQW + u.pn] = (v0 + v1) + (v2 + v3);
            }
        }
    }
};
DI void prep_tables(unsigned char* ws, int vb, int vg, HB& hb) {
    float2* rope = (float2*)(ws + WS_ROPE);
    bf16_t* w1a = (bf16_t*)(ws + WS_W1_64);
    bf16_t* w1b = (bf16_t*)(ws + WS_W1_128);
    bf16_t* w2 = (bf16_t*)(ws + WS_W2_64);
    const int gt = vb * 256 + TID256(hb), gs = vg * 256;
    for (int i = gt; i < 128 * 16; i += gs) {
        const int pos = i >> 4, f = i & 15;
        const float freq = exp2f(-(float)f * (13.287712379549449f / 16.0f));
        float s, c; sincosf((float)pos * freq, &s, &c);
        rope[i] = make_float2(c, s);
    }
    for (int i = gt; i < 128 * 128; i += gs) {
        const int m = i >> 7, k = i & 127, mm = m & 63, kk = k & 63;
        float s, c; sincospif((float)((mm * kk) & 63) / 32.0f, &s, &c);
        c *= 0.125f; s *= 0.125f;
        const float v = (m < 64) ? (k < 64 ? c : s) : (k < 64 ? -s : c);
        w1a[i] = f2bf(v);
    }
    for (int i = gt; i < 256 * 256; i += gs) {
        const int m = i >> 8, k = i & 255, mm = m & 127, kk = k & 127;
        float s, c; sincospif((float)((mm * kk) & 127) / 64.0f, &s, &c);
        c *= 0.08838834764831845f; s *= 0.08838834764831845f;
        const float v = (m < 128) ? (k < 128 ? c : s) : (k < 128 ? -s : c);
        w1b[i] = f2bf(v);
    }
    for (int i = gt; i < 64 * 128; i += gs) {
        const int m = i >> 7, k = i & 127, kk = k & 63;
        float s, c; sincospif((float)((m * kk) & 63) / 32.0f, &s, &c);
        w2[i] = f2bf((k < 64 ? c : s) * 0.125f);
    }
}

DI void tok_info(int tok, int& S, int& seq_tok0, int& s) {
    if (tok < MP) { S = 4096; seq_tok0 = tok & ~4095; s = tok & 4095; }
    else { S = 8192; seq_tok0 = MP + ((tok - MP) & ~8191); s = (tok - MP) & 8191; }
}

struct EpiZ0 {
    static constexpr bool PERM = true, AFTER_DRAIN = false;
    bf16_t* Z; const float* ssq;
    DI void operator()(const f32x4 (&acc)[2][2][4][2], const pg8::Unit& u, int wr, int wc, int fr, int fq) const {
        const int row0 = u.pm * 256 + wr * 64 + fr, col0 = 256 + u.pn * 256 + wc * 32 + 8 * fq;
#pragma unroll
        for (int ai = 0; ai < 2; ++ai)
#pragma unroll
            for (int m = 0; m < 4; ++m) {
                const int row = row0 + ai * 128 + m * 16;
                const float r = row_rstd(ssq, row);
#pragma unroll
                for (int bj = 0; bj < 2; ++bj) {
                    const f32x4 v0 = acc[ai][bj][m][0] * r, v1 = acc[ai][bj][m][1] * r;
                    *(uint4*)(Z + (size_t)row * ZW + col0 + bj * 128) = make_uint4(pack2(v0[0], v0[1]), pack2(v0[2], v0[3]), pack2(v1[0], v1[1]), pack2(v1[2], v1[3]));
                }
            }
    }
};

DI void qkprep_phase(bf16_t* __restrict__ z0, bf16_t* __restrict__ vt, const float* __restrict__ qn, const float* __restrict__ kn, const float2* __restrict__ rope, char* smem, int vb, int vg, HB& hb) {
    bf16_t* T = (bf16_t*)smem;
    float* gq = (float*)(smem + 64 * 264 * 2);
    const int tid = launder(TID256(hb));
    if (tid < 64) { gq[tid] = qn[tid]; gq[64 + tid] = kn[tid]; }
    hb_sync(hb);
    for (int u = vb; u < MTOK / 64; u += vg) {
        const int tok0 = u * 64;
        int S, seq0, s0; tok_info(tok0, S, seq0, s0);
        const int row_id = s0 >> 6;
#pragma unroll 1
        for (int it = 0; it < 4; ++it) {
            const int pidx = tid + 256 * it, tk = pidx >> 4, hh = pidx & 15;
            const bool isq = hh < 12;
            bf16_t* ptr = z0 + (size_t)(tok0 + tk) * ZW + (isq ? 256 + hh * 64 : 1536 + (hh - 12) * 64);
            const float* gg = gq + (isq ? 0 : 64);
            float x[64];
#pragma unroll
            for (int c = 0; c < 8; ++c) {
                const uint4 v = ((const uint4*)ptr)[c];
                const unsigned wv[4] = {v.x, v.y, v.z, v.w};
#pragma unroll
                for (int q = 0; q < 4; ++q) { x[c * 8 + 2 * q] = __uint_as_float(wv[q] << 16); x[c * 8 + 2 * q + 1] = __uint_as_float(wv[q] & 0xffff0000u); }
            }
            float ss = 0.f;
#pragma unroll
            for (int d = 0; d < 64; ++d) ss += x[d] * x[d];
            float r = rsqrtf(ss * (1.0f / 64.0f) + EPS);
#pragma unroll
            for (int d = 0; d < 64; ++d) x[d] = x[d] * r * gg[d];
            const float sc = isq ? 0.125f * 1.4426950408889634f : 1.0f;
            const float2* rr = rope + row_id * 16;
            const float2* rc = rope + tk * 16;
            float y[64];
#pragma unroll
            for (int f = 0; f < 16; ++f) {
                const float2 a = rr[f], b = rc[f];
                y[f] = (x[f] * a.x - x[16 + f] * a.y) * sc;
                y[16 + f] = (x[f] * a.y + x[16 + f] * a.x) * sc;
                y[32 + f] = (x[32 + f] * b.x - x[48 + f] * b.y) * sc;
                y[48 + f] = (x[32 + f] * b.y + x[48 + f] * b.x) * sc;
            }
#pragma unroll
            for (int c = 0; c < 8; ++c)
                ((uint4*)ptr)[c] = make_uint4(pack2(y[c * 8], y[c * 8 + 1]), pack2(y[c * 8 + 2], y[c * 8 + 3]), pack2(y[c * 8 + 4], y[c * 8 + 5]), pack2(y[c * 8 + 6], y[c * 8 + 7]));
        }
        hb_sync(hb);
#pragma unroll
        for (int it = 0; it < 8; ++it) {
            const int pidx = tid + 256 * it, tk = pidx >> 5, c8 = (pidx & 31) * 8;
            *(uint4*)(T + tk * 264 + c8) = *(const uint4*)(z0 + (size_t)(tok0 + tk) * ZW + 1792 + c8);
        }
        hb_sync(hb);
        {
            unsigned o[32];
#pragma unroll
            for (int j = 0; j < 32; ++j) o[j] = (unsigned)T[(2 * j) * 264 + tid] | ((unsigned)T[(2 * j + 1) * 264 + tid] << 16);
            uint4* dp = (uint4*)(vt + (size_t)seq0 * 256 + (size_t)tid * S + s0);
#pragma unroll
            for (int j = 0; j < 8; ++j) dp[j] = make_uint4(o[4 * j], o[4 * j + 1], o[4 * j + 2], o[4 * j + 3]);
        }
    }
    hb_sync(hb);
}

template <int NR>
DI void fourier_ld(const bf16_t* __restrict__ z0, uint4 (&rg)[NR / 16], int rowbase, int rowstride, int cb, int tid) {
#pragma unroll
    for (int it = 0; it < NR / 16; ++it) {
        const int pidx = tid + 256 * it, k = pidx >> 3, c8 = (pidx & 7) * 8;
        const int kk = k & (NR - 1);
        rg[it] = *(const uint4*)(z0 + (size_t)(rowbase + kk * rowstride) * ZW + 1024 + (k >= NR ? 256 : 0) + cb * 64 + c8);
    }
}
template <int NR, int TS>
DI void fourier_st(const uint4 (&rg)[NR / 16], bf16_t* T, int tid) {
#pragma unroll
    for (int it = 0; it < NR / 16; ++it) {
        const int pidx = tid + 256 * it, k = pidx >> 3, c8 = (pidx & 7) * 8;
        const unsigned wv[4] = {rg[it].x, rg[it].y, rg[it].z, rg[it].w};
#pragma unroll
        for (int q = 0; q < 4; ++q) { T[(c8 + 2 * q) * TS + k] = (bf16_t)(wv[q] & 0xffffu); T[(c8 + 2 * q + 1) * TS + k] = (bf16_t)(wv[q] >> 16); }
    }
}

template <int N1>
DI void fourier_stage1(bf16_t* __restrict__ z0, int tok_base, int nseq, const bf16_t* __restrict__ W1, char* smem, int vb, int vg, HB& hb) {
    constexpr int TS = 2 * N1 + 8, S = N1 * 64, KST = N1 / 8;
    constexpr int NNB = (N1 == 64) ? 1 : 2;
    bf16_t* T = (bf16_t*)smem;
    const int tid = launder(TID256(hb)), lane = tid & 63, w = tid >> 6, l31 = lane & 31, lh = lane >> 5;
    const int wp = (N1 == 64) ? (w & 1) : w, nb0 = (N1 == 64) ? (w >> 1) : 0;
    const int total = nseq * 64 * 4;
    uint4 rg[N1 / 16];
    if (vb < total) fourier_ld<N1>(z0, rg, tok_base + (vb >> 8) * S + ((vb >> 2) & 63), 64, vb & 3, tid);
    for (int u = vb; u < total; u += vg) {
        const int cb = u & 3, s2 = (u >> 2) & 63, b = u >> 8;
        const int rowbase = tok_base + b * S + s2;
        hb_sync(hb);
        fourier_st<N1, TS>(rg, T, tid);
        hb_sync(hb);
        { const int un = (u + vg < total) ? u + vg : u;
          fourier_ld<N1>(z0, rg, tok_base + (un >> 8) * S + ((un >> 2) & 63), 64, un & 3, tid); }
        f32x16 are[NNB], aim[NNB];
#pragma unroll
        for (int n = 0; n < NNB; ++n)
#pragma unroll
            for (int i = 0; i < 16; ++i) { are[n][i] = 0.f; aim[n][i] = 0.f; }
        const bf16_t* wre = W1 + (size_t)(32 * wp + l31) * (2 * N1) + lh * 8;
        const bf16_t* wim = wre + (size_t)N1 * (2 * N1);
#pragma unroll 4
        for (int ks = 0; ks < KST; ++ks) {
            const bf16x8 ar = *(const bf16x8*)(wre + ks * 16), ai = *(const bf16x8*)(wim + ks * 16);
#pragma unroll
            for (int n = 0; n < NNB; ++n) {
                const bf16x8 bb = *(const bf16x8*)(T + ((nb0 + n) * 32 + l31) * TS + ks * 16 + lh * 8);
                are[n] = MFMA32(ar, bb, are[n]); aim[n] = MFMA32(ai, bb, aim[n]);
            }
        }
#pragma unroll
        for (int i = 0; i < 16; ++i) {
            const int s1p = 32 * wp + acc_row(i, lh);
            float sn, cs; sincospif(-2.0f * (float)(s2 * s1p) / (float)S, &sn, &cs);
            bf16_t* dst = z0 + (size_t)(rowbase + s1p * 64) * ZW + 1024 + cb * 64;
#pragma unroll
            for (int n = 0; n < NNB; ++n) {
                const float re = are[n][i], im = aim[n][i];
                const int c = (nb0 + n) * 32 + l31;
                dst[c] = f2bf(re * cs - im * sn);
                dst[256 + c] = f2bf(re * sn + im * cs);
            }
        }
    }
    hb_sync(hb);
}

DI void fourier_stage2(bf16_t* __restrict__ z0, int tok_base, int nseq, int N1, const bf16_t* __restrict__ W2, char* smem, int vb, int vg, HB& hb) {
    constexpr int TS = 136;
    bf16_t* T = (bf16_t*)smem;
    const int tid = launder(TID256(hb)), lane = tid & 63, w = tid >> 6, l31 = lane & 31, lh = lane >> 5;
    const int mb = w & 1, nb = w >> 1;
    const int S = N1 * 64, total = nseq * N1 * 4;
    uint4 rg[4];
    if (vb < total) { const int r0 = vb >> 2; fourier_ld<64>(z0, rg, tok_base + (r0 / N1) * S + (r0 % N1) * 64, 1, vb & 3, tid); }
    for (int u = vb; u < total; u += vg) {
        const int cb = u & 3, r = u >> 2, s1p = r % N1, b = r / N1;
        const int rowbase = tok_base + b * S + s1p * 64;
        hb_sync(hb);
        fourier_st<64, TS>(rg, T, tid);
        hb_sync(hb);
        { const int un = (u + vg < total) ? u + vg : u; const int rn = un >> 2;
          fourier_ld<64>(z0, rg, tok_base + (rn / N1) * S + (rn % N1) * 64, 1, un & 3, tid); }
        f32x16 acc;
#pragma unroll
        for (int i = 0; i < 16; ++i) acc[i] = 0.f;
        const bf16_t* wr_ = W2 + (size_t)(32 * mb + l31) * 128 + lh * 8;
#pragma unroll
        for (int ks = 0; ks < 8; ++ks) {
            const bf16x8 a = *(const bf16x8*)(wr_ + ks * 16);
            const bf16x8 bb = *(const bf16x8*)(T + (nb * 32 + l31) * TS + ks * 16 + lh * 8);
            acc = MFMA32(a, bb, acc);
        }
#pragma unroll
        for (int i = 0; i < 16; ++i) {
            const int s2p = 32 * mb + acc_row(i, lh);
            z0[(size_t)(tok_base + b * S + s1p + N1 * s2p) * ZW + cb * 64 + nb * 32 + l31] = f2bf(acc[i]);
        }
    }
    hb_sync(hb);
}

#define ATT_SCORES_PV(KSB, VSB)                                                                                             \
    {                                                                                                                       \
        f32x16 s[2][2];                                                                                                     \
        {     \
            const bf16x8 k0 = *(const bf16x8*)((KSB) + l31 * KS_ + lh * 8);                                                 \
            const bf16x8 k1 = *(const bf16x8*)((KSB) + (32 + l31) * KS_ + lh * 8);                                          \
            const bf16x8 q0 = *(const bf16x8*)(Qw + l31 * KS_ + lh * 8);                                                    \
            const bf16x8 q1 = *(const bf16x8*)(Qw + (32 + l31) * KS_ + lh * 8);                                             \
            s[0][0] = MFMA32(k0, q0, negmb); s[0][1] = MFMA32(k0, q1, negmb);                                               \
            s[1][0] = MFMA32(k1, q0, negmb); s[1][1] = MFMA32(k1, q1, negmb);                                               \
        }                                                                                                                   \
        _Pragma("unroll") for (int ks = 1; ks < 4; ++ks) {                                                                  \
            const bf16x8 k0 = *(const bf16x8*)((KSB) + l31 * KS_ + ks * 16 + lh * 8);                                       \
            const bf16x8 k1 = *(const bf16x8*)((KSB) + (32 + l31) * KS_ + ks * 16 + lh * 8);                                \
            const bf16x8 q0 = *(const bf16x8*)(Qw + l31 * KS_ + ks * 16 + lh * 8);                                          \
            const bf16x8 q1 = *(const bf16x8*)(Qw + (32 + l31) * KS_ + ks * 16 + lh * 8);                                   \
            s[0][0] = MFMA32(k0, q0, s[0][0]); s[0][1] = MFMA32(k0, q1, s[0][1]);                                           \
            s[1][0] = MFMA32(k1, q0, s[1][0]); s[1][1] = MFMA32(k1, q1, s[1][1]);                                           \
        }                                                                                                                   \
        bf16x8 pf[2][4];                                                                                                    \
        _Pragma("unroll") for (int qb = 0; qb < 2; ++qb) {                                                                  \
            float ps = 0.f;                                                                                                 \
            _Pragma("unroll") for (int kb = 0; kb < 2; ++kb) {                                                              \
                _Pragma("unroll") for (int i = 0; i < 16; ++i) { const float pv = __builtin_amdgcn_exp2f(s[kb][qb][i]); s[kb][qb][i] = pv; ps += pv; } \
                _Pragma("unroll") for (int sp = 0; sp < 2; ++sp) {                                                          \
                    u32x4 pk;                                                                                               \
                    pk[0] = pack2(s[kb][qb][8 * sp + 0], s[kb][qb][8 * sp + 1]); pk[1] = pack2(s[kb][qb][8 * sp + 2], s[kb][qb][8 * sp + 3]); \
                    pk[2] = pack2(s[kb][qb][8 * sp + 4], s[kb][qb][8 * sp + 5]); pk[3] = pack2(s[kb][qb][8 * sp + 6], s[kb][qb][8 * sp + 7]); \
                    pf[qb][kb * 2 + sp] = __builtin_bit_cast(bf16x8, pk);                                                   \
                }                                                                                                           \
            }                                                                                                               \
            lsum[qb] += ps;                                                                                                 \
        }                                                                                                                   \
        _Pragma("unroll") for (int kst = 0; kst < 4; ++kst) {                                                               \
            _Pragma("unroll") for (int db = 0; db < 2; ++db) {                                                              \
                const bf16_t* vrow = (VSB) + (db * 32 + l31) * KS_ + kst * 16 + lh * 4;                                     \
                const s16x4 lo = *(const s16x4*)(vrow), hi = *(const s16x4*)(vrow + 8);                                     \
                const bf16x8 vf = __builtin_shufflevector(lo, hi, 0, 1, 2, 3, 4, 5, 6, 7);                                  \
                o[db][0] = MFMA32(vf, pf[0][kst], o[db][0]);                                                                \
                o[db][1] = MFMA32(vf, pf[1][kst], o[db][1]);                                                                \
            }                                                                                                               \
        }                                                                                                                   \
    }
DI void attn_phase(bf16_t* __restrict__ z0, const bf16_t* __restrict__ vt, const float* __restrict__ qn, const float* __restrict__ kn, char* lds0, int wv8) {
    constexpr int KS_ = 72;
    bf16_t* Ks = (bf16_t*)lds0;
    bf16_t* Vs = Ks + 2 * 64 * KS_;
    bf16_t* Qw = Vs + 2 * 64 * KS_ + wv8 * 64 * KS_;
    const int tid = launder((wv8 << 6) | lane_id()), lane = tid & 63, w = tid >> 6, l31 = lane & 31, lh = lane >> 5;
    const int lr = tid >> 3, lc = (tid & 7) * 8;
    float mb;
    {
        float gq = fabsf(qn[lane]), gk = fabsf(kn[lane]);
#pragma unroll
        for (int off = 1; off < 64; off <<= 1) { gq = fmaxf(gq, xshfl(gq, off)); gk = fmaxf(gk, xshfl(gk, off)); }
        mb = 8.0f * 1.4426950408889634f * gq * gk;
    }
    f32x16 negmb;
#pragma unroll
    for (int i = 0; i < 16; ++i) negmb[i] = -mb;
    for (int t = blockIdx.x; t < 3072; t += gridDim.x) {
        const int x = t & 7, j = t >> 3;
        int S, seq0, kvh, qblk, g;
        if (j < 192) { const int pair = x * 4 + j / 48, r = j % 48; S = 8192; seq0 = MP + (pair >> 2) * 8192; kvh = pair & 3; qblk = r / 3; g = r % 3; }
        else { const int jj = j - 192, pair = x * 8 + jj / 24, r = jj % 24; S = 4096; seq0 = (pair >> 2) * 4096; kvh = pair & 3; qblk = r / 3; g = r % 3; }
        const int hq = kvh * 3 + g;
        const int qrow0 = seq0 + qblk * 512 + w * 64;
        __syncthreads();
        {
            const bf16_t* qsrc = z0 + (size_t)qrow0 * ZW + 256 + hq * 64;
            const int ln = launder(lane);
            const int r0 = ln >> 3, c8 = (ln & 7) * 8;
            const unsigned go = (unsigned)(r0 * ZW + c8); const int lo = r0 * KS_ + c8;
#pragma unroll
            for (int i = 0; i < 8; ++i)
                *(uint4*)(Qw + lo + i * 8 * KS_) = *(const uint4*)(qsrc + go + (unsigned)(i * 8 * ZW));
        }
        const bf16_t* kp = z0 + (size_t)seq0 * ZW + 1536 + kvh * 64;
        const bf16_t* vp = vt + (size_t)seq0 * 256 + (size_t)(kvh * 64) * S;
        const unsigned offk = (unsigned)(lr * ZW + lc), offv = (unsigned)(lr * S + lc);
        const int lo4 = lr * KS_ + lc;
        const int nkt = S >> 6;
        uint4 rkA = *(const uint4*)(kp + offk), rvA = *(const uint4*)(vp + offv);
        *(uint4*)(Ks + lo4) = rkA; *(uint4*)(Vs + lo4) = rvA;
        __syncthreads();
        f32x16 o[2][2];
#pragma unroll
        for (int a = 0; a < 2; ++a)
#pragma unroll
            for (int b = 0; b < 2; ++b)
#pragma unroll
                for (int i = 0; i < 16; ++i) o[a][b][i] = 0.f;
        float lsum[2] = {0.f, 0.f};
        for (int kt = 0; kt < nkt; ++kt) {
            const int buf = kt & 1;
            if (kt + 1 < nkt) { rkA = *(const uint4*)(kp + (size_t)((kt + 1) * 64) * ZW + offk); rvA = *(const uint4*)(vp + (kt + 1) * 64 + offv); }
            const bf16_t* ksb = Ks + buf * 64 * KS_; const bf16_t* vsb = Vs + buf * 64 * KS_;
            ATT_SCORES_PV(ksb, vsb)
            if (kt + 1 < nkt) { *(uint4*)(Ks + (buf ^ 1) * 64 * KS_ + lo4) = rkA; *(uint4*)(Vs + (buf ^ 1) * 64 * KS_ + lo4) = rvA; }
            __syncthreads();
        }
        const int t3 = launder(tid);
        const int row3 = seq0 + qblk * 512 + (t3 >> 6) * 64 + (t3 & 31), lh3 = (t3 >> 5) & 1;
#pragma unroll
        for (int qb = 0; qb < 2; ++qb) {
            const float l = lsum[qb] + xshfl(lsum[qb], 32);
            const float inv = 1.0f / l;
            bf16_t* dst = z0 + (size_t)(row3 + qb * 32) * ZW + 256 + hq * 64;
#pragma unroll
            for (int db = 0; db < 2; ++db)
#pragma unroll
                for (int g4 = 0; g4 < 4; ++g4) {
                    u32x2 pk;
                    pk[0] = pack2(o[db][qb][4 * g4] * inv, o[db][qb][4 * g4 + 1] * inv);
                    pk[1] = pack2(o[db][qb][4 * g4 + 2] * inv, o[db][qb][4 * g4 + 3] * inv);
                    *(u32x2*)(dst + db * 32 + 8 * g4 + 4 * lh3) = pk;
                }
        }
    }
    __syncthreads();
}

struct EpiZ1 {
    static constexpr bool PERM = true, AFTER_DRAIN = false;
    bf16_t* Z; float* G; const float* bias; const float* ssq;
    DI void operator()(const f32x4 (&acc)[2][2][4][2], const pg8::Unit& u, int wr, int wc, int fr, int fq) const {
        const int row0 = u.pm * 256 + wr * 64 + fr, col0 = u.pn * 256 + wc * 32 + 8 * fq;
#pragma unroll
        for (int ai = 0; ai < 2; ++ai)
#pragma unroll
            for (int m = 0; m < 4; ++m) {
                const int row = row0 + ai * 128 + m * 16;
                const float r = row_rstd(ssq, row);
#pragma unroll
                for (int bj = 0; bj < 2; ++bj) {
                    const int col = col0 + bj * 128;
                    const f32x4 v0 = acc[ai][bj][m][0] * r, v1 = acc[ai][bj][m][1] * r;
                    if (col < 4096) {
                        *(uint4*)(Z + (size_t)row * 4096 + col) = make_uint4(pack2(v0[0], v0[1]), pack2(v0[2], v0[3]), pack2(v1[0], v1[1]), pack2(v1[2], v1[3]));
                    } else if (col < 4112) {
                        const float4 b0 = *(const float4*)(bias + (col - 4096)), b1 = *(const float4*)(bias + (col - 4096) + 4);
                        float* gp = G + (size_t)row * 16 + (col - 4096);
                        *(float4*)gp = make_float4(v0[0] + b0.x, v0[1] + b0.y, v0[2] + b0.z, v0[3] + b0.w);
                        *(float4*)(gp + 4) = make_float4(v1[0] + b1.x, v1[1] + b1.y, v1[2] + b1.z, v1[3] + b1.w);
                    }
                }
            }
    }
};

#define BLO(u) __uint_as_float((u) << 16)
#define BHI(u) __uint_as_float((u) & 0xffff0000u)
DI void conv_load(const bf16_t* __restrict__ z1, int col, int tok0, int s0, int S, int r0, uint4 (&rows)[10]) {
#pragma unroll
    for (int i = 0; i < 10; ++i) {
        const int r = r0 - 1 + i, sq = s0 + r;
        rows[i] = make_uint4(0, 0, 0, 0);
        if (sq >= 0 && sq < S) rows[i] = *(const uint4*)(z1 + (size_t)(tok0 + r) * 4096 + col);
    }
}
DI void conv_apply(const uint4 (&rows)[10], const float* __restrict__ cw, int col, int tok0, int r0, float osc, bf16_t* T, int c8, bf16_t* __restrict__ gdst) {
    float w0[8], w1[8], w2[8];
#pragma unroll
    for (int e = 0; e < 8; ++e) { w0[e] = cw[col + e]; w1[e] = cw[2048 + col + e]; w2[e] = cw[4096 + col + e]; }
#pragma unroll
    for (int i = 0; i < 8; ++i) {
        const uint4 p = rows[i], c = rows[i + 1], n = rows[i + 2];
        const float xp[8] = {BLO(p.x), BHI(p.x), BLO(p.y), BHI(p.y), BLO(p.z), BHI(p.z), BLO(p.w), BHI(p.w)};
        const float xc[8] = {BLO(c.x), BHI(c.x), BLO(c.y), BHI(c.y), BLO(c.z), BHI(c.z), BLO(c.w), BHI(c.w)};
        const float xn[8] = {BLO(n.x), BHI(n.x), BLO(n.y), BHI(n.y), BLO(n.z), BHI(n.z), BLO(n.w), BHI(n.w)};
        float y[8];
#pragma unroll
        for (int e = 0; e < 8; ++e) {
            const float a = xp[e] * w0[e] + xc[e] * w1[e] + xn[e] * w2[e];
            y[e] = a * __builtin_amdgcn_rcpf(1.0f + __builtin_amdgcn_exp2f(-1.4426950408889634f * a)) * osc;
        }
        const uint4 ov = make_uint4(pack2(y[0], y[1]), pack2(y[2], y[3]), pack2(y[4], y[5]), pack2(y[6], y[7]));
        const int r = r0 + i;
        if (gdst) *(uint4*)(gdst + (size_t)(tok0 + r) * 1024 + c8) = ov;
        *(uint4*)(T + r * 264 + c8) = ov;
    }
}
DI void transpose_out(const bf16_t* T, bf16_t* __restrict__ base, HB& hb) {
    const int tid = launder(TID256(hb));
    unsigned o[32];
#pragma unroll
    for (int j = 0; j < 32; ++j) o[j] = (unsigned)T[(2 * j) * 264 + tid] | ((unsigned)T[(2 * j + 1) * 264 + tid] << 16);
#pragma unroll
    for (int j = 0; j < 8; ++j) ((uint4*)base)[j] = make_uint4(o[4 * j], o[4 * j + 1], o[4 * j + 2], o[4 * j + 3]);
}
DI void conv_phase(const bf16_t* __restrict__ z1, bf16_t* __restrict__ qc, bf16_t* __restrict__ kT, bf16_t* __restrict__ vT, bf16_t* __restrict__ sfr,
                   const float* __restrict__ gates, float4* __restrict__ gsc, const float* __restrict__ cw, int S, int gtok, char* smem, int vb, int vg, HB& hb) {
    bf16_t* TQ = (bf16_t*)smem;
    bf16_t* TK = TQ + 64 * 264;
    const int tid = launder(TID256(hb)), rg = tid >> 5, c8 = (tid & 31) * 8;
    const int lane = tid & 63, w = tid >> 6, l31 = lane & 31, lh = lane >> 5, jb = w & 1, eb = w >> 1;
    const int total = (gtok / 64) * 4;
    for (int u = vb; u < total; u += vg) {
        const int hd = u & 3, blk = u >> 2;
        const int tok0 = blk * 64, s0 = tok0 % S, seq = tok0 / S;
        const size_t tbase = ((size_t)(seq * 4 + hd) * 256 + tid) * S + s0;
        hb_sync(hb);
        uint4 vrow[8], qrow[10], krow[10];
#pragma unroll
        for (int i = 0; i < 8; ++i) vrow[i] = *(const uint4*)(z1 + (size_t)(tok0 + rg * 8 + i) * 4096 + 2048 + hd * 256 + c8);
        conv_load(z1, hd * 256 + c8, tok0, s0, S, rg * 8, qrow);
        conv_load(z1, 1024 + hd * 256 + c8, tok0, s0, S, rg * 8, krow);
#pragma unroll
        for (int i = 0; i < 8; ++i) *(uint4*)(TQ + (rg * 8 + i) * 264 + c8) = vrow[i];
        hb_sync(hb);
        transpose_out(TQ, vT + tbase, hb);
        hb_sync(hb);
        conv_apply(qrow, cw, hd * 256 + c8, tok0, rg * 8, 1.0f, TQ, c8, qc + hd * 256);
        conv_apply(krow, cw, 1024 + hd * 256 + c8, tok0, rg * 8, 0.0625f, TK, c8, nullptr);
        hb_sync(hb);
        transpose_out(TK, kT + tbase, hb);
        f32x16 acc;
#pragma unroll
        for (int i = 0; i < 16; ++i) acc[i] = 0.f;
#pragma unroll 4
        for (int ks = 0; ks < 16; ++ks) {
            const bf16x8 kf = *(const bf16x8*)(TK + (eb * 32 + l31) * 264 + ks * 16 + lh * 8);
            const bf16x8 qf = *(const bf16x8*)(TQ + (jb * 32 + l31) * 264 + ks * 16 + lh * 8);
            acc = MFMA32(kf, qf, acc);
        }
        if (w < 2) {
            const int dir = w, r = dir ? 63 - lane : lane;
            const float ig = gates[(size_t)(tok0 + r) * 16 + dir * 8 + hd], fg = gates[(size_t)(tok0 + r) * 16 + dir * 8 + 4 + hd];
            float bcs = fminf(fg, 0.f) - __logf(1.0f + __expf(-fabsf(fg)));
#pragma unroll
            for (int off = 1; off < 64; off <<= 1) { const float tt = bperm(bcs, lane - off); if (lane >= off) bcs += tt; }
            const float av = ig - bcs;
            float cm = av;
#pragma unroll
            for (int off = 1; off < 64; off <<= 1) { const float tt = bperm(cm, lane - off); if (lane >= off) cm = fmaxf(cm, tt); }
            gsc[((size_t)(blk * 4 + hd) * 2 + dir) * 64 + lane] = make_float4(bcs, av, cm, 0.f);
        }
        uint4* sd = (uint4*)(sfr + ((size_t)(blk * 4 + hd) * 256 + tid) * 16);
        sd[0] = make_uint4(pack2(acc[0], acc[1]), pack2(acc[2], acc[3]), pack2(acc[4], acc[5]), pack2(acc[6], acc[7]));
        sd[1] = make_uint4(pack2(acc[8], acc[9]), pack2(acc[10], acc[11]), pack2(acc[12], acc[13]), pack2(acc[14], acc[15]));
    }
    hb_sync(hb);
}

DI uint4 scale8(uint4 v, const float* wsp) {
    return make_uint4(pack2(BLO(v.x) * wsp[0], BHI(v.x) * wsp[1]), pack2(BLO(v.y) * wsp[2], BHI(v.y) * wsp[3]),
                      pack2(BLO(v.z) * wsp[4], BHI(v.z) * wsp[5]), pack2(BLO(v.w) * wsp[6], BHI(v.w) * wsp[7]));
}
DI void mlstm_phase(const bf16_t* __restrict__ qc, const bf16_t* __restrict__ kT, const bf16_t* __restrict__ vT, const bf16_t* __restrict__ sfr,
                    const float4* __restrict__ gsc, bf16_t* __restrict__ hout  , int S, int nseq, char* lds0, int wv8) {
    constexpr int LS = 72, TILE = 64 * LS;
    const int sub = wv8 >> 2;
    bf16_t* QS = (bf16_t*)lds0 + sub * 3 * TILE;
    bf16_t* KT = QS + TILE;
    bf16_t* CL = KT + TILE;
    bf16_t* VT = (bf16_t*)lds0 + 6 * TILE;
    bf16_t* PL = VT + 2 * TILE;
    float* NV = (float*)(PL + TILE);
    bf16_t* NVB = (bf16_t*)(NV + 512);
    float* TA = NV + 512 + 256;
    float* TM = TA + 64;
    float* TWI = TM + 64;
    float* TEL = TWI + 64;
    float* TNQ = TEL + 64;
    float* TRS = TNQ + 128;
    float* IX = TRS + 128;
    const int lane = launder(lane_id()), w = wv8 & 3, l31 = lane & 31, lh = lane >> 5;
    const int t8 = (w << 6) | lane;
    const int jb = w & 1, eb = w >> 1, db = w & 1;
    const int lr = t8 >> 3, lc = (t8 & 7) * 8;
    const int nC = S >> 6;
    const int total = nseq * 32;
    const unsigned offq0 = (unsigned)(lr * 1024 + lc), offq1 = (unsigned)((lr + 32) * 1024 + lc);
    const unsigned offt0 = (unsigned)(lr * S + lc), offt1 = (unsigned)((lr + 32) * S + lc);
    for (int u = blockIdx.x; u < total; u += gridDim.x) {
        const int es = u & 3, dir = (u >> 2) & 1, hd = (u >> 3) & 3, seq = u >> 5;
        const size_t tokseq = (size_t)seq * S;
        const bf16_t* qg = qc + tokseq * 1024 + hd * 256;
        const bf16_t* sg = sfr + ((size_t)(seq * nC) * 4 + hd) * 4096;
        const bf16_t* kTg = kT + (size_t)(seq * 4 + hd) * 256 * S;
        const bf16_t* vTg = vT + ((size_t)(seq * 4 + hd) * 256 + es * 64) * S;
        const float4* gg = gsc + ((size_t)(seq * nC) * 4 + hd) * 128 + dir * 64;
        f32x16 ct0, ct1;
#pragma unroll
        for (int i = 0; i < 16; ++i) { ct0[i] = 0.f; ct1[i] = 0.f; }
        float mst = 0.f;
        __syncthreads();
        { const int t2 = launder(t8) + sub * 256; NV[t2] = 0.f; NVB[t2] = 0; }
        uint4 rqX0, rqX1, rtX0, rtX1, rqY0, rqY1, rtY0, rtY1, rv0, rv1, rs0, rs1;
        float4 gs_n;
        {
            const int s0 = (dir ? nC - 1 : 0) * 64;
            const bf16_t* qb_ = qg + (size_t)s0 * 1024 + sub * 64;
            const bf16_t* tb_ = kTg + (size_t)(sub * 64) * S + s0;
            rqX0 = *(const uint4*)(qb_ + offq0); rqX1 = *(const uint4*)(qb_ + offq1);
            rtX0 = *(const uint4*)(tb_ + offt0); rtX1 = *(const uint4*)(tb_ + offt1);
            rqY0 = *(const uint4*)(qb_ + 128 + offq0); rqY1 = *(const uint4*)(qb_ + 128 + offq1);
            rtY0 = *(const uint4*)(tb_ + (size_t)128 * S + offt0); rtY1 = *(const uint4*)(tb_ + (size_t)128 * S + offt1);
            gs_n = gg[(size_t)(s0 >> 6) * 512 + lane];
            if (sub == 0) {
                const bf16_t* vb_ = vTg + s0; rv0 = *(const uint4*)(vb_ + offt0); rv1 = *(const uint4*)(vb_ + offt1);
                *(uint4*)(VT + lr * LS + lc) = rv0; *(uint4*)(VT + (lr + 32) * LS + lc) = rv1;
            }
        }
        for (int c = 0; c < nC; ++c) {
            const int par = c & 1;
            const int s0 = (dir ? nC - 1 - c : c) * 64;
            const int s0n = (dir ? nC - 2 - c : c + 1) * 64;
            const bool has_next = c + 1 < nC;
            const int ll = launder(lane);
            const float bcs = gs_n.x, av = gs_n.y, cm = gs_n.z;
            const float Mj = fmaxf(mst, cm);
            const float wi = __expf(mst - Mj);
            const float el = __expf(-(bcs + Mj));
            const float M63 = rdlane(Mj, 63);
            const float wsv = __expf(av - M63);
            const float decay = rdlane(wi, 63);
            const float mnew = rdlane(bcs, 63) + M63;
            if (has_next) gs_n = gg[(size_t)(s0n >> 6) * 512 + ll];
            f32x16 iacc;
#pragma unroll
            for (int i = 0; i < 16; ++i) iacc[i] = 0.f;
            float nqp = 0.f;
            const float* nvo = NV + par * 256;
            float* nvn = NV + (par ^ 1) * 256;
            const bf16_t* nbo = NVB + par * 256;
            bf16_t* nbn = NVB + (par ^ 1) * 256;
            const bf16_t* VTU = VT + par * TILE;
#define MLSTM_IT(it, CT, rq0, rq1, rt0, rt1)                                                                               \
            {                                                                                                              \
                const int dc = 2 * it + sub;                                                                               \
                __syncthreads();                                                                             \
                {                                                                                                          \
                    float wsp[8];                                                                                          \
                    const int lcl = launder(lc);                                                                           \
                    _Pragma("unroll") for (int e = 0; e < 8; ++e) { const int r = lcl + e; wsp[e] = bperm(wsv, dir ? 63 - r : r); } \
                    *(uint4*)(QS + lr * LS + lc) = rq0; *(uint4*)(QS + (lr + 32) * LS + lc) = rq1;                        \
                    *(uint4*)(KT + lr * LS + lc) = scale8(rt0, wsp); *(uint4*)(KT + (lr + 32) * LS + lc) = scale8(rt1, wsp); \
                }                                                                                                          \
                _Pragma("unroll") for (int g4 = 0; g4 < 4; ++g4) {                                                         \
                    u32x2 pk;                                                                                              \
                    pk[0] = pack2(CT[4 * g4], CT[4 * g4 + 1]); pk[1] = pack2(CT[4 * g4 + 2], CT[4 * g4 + 3]);              \
                    *(u32x2*)(CL + (eb * 32 + l31) * LS + db * 32 + 8 * g4 + 4 * lh) = pk;                                 \
                }                                                                                                          \
                if (it == 0 && wv8 == 0) { const int r = dir ? 63 - ll : ll; TA[r] = av; TM[r] = Mj; TWI[r] = wi; TEL[r] = el; } \
                if (it == 1 && has_next && sub == 0) { bf16_t* vn = VT + (par ^ 1) * TILE; *(uint4*)(vn + lr * LS + lc) = rv0; *(uint4*)(vn + (lr + 32) * LS + lc) = rv1; } \
                __syncthreads();                                                                             \
                if (has_next) {     \
                    const bf16_t* qb_ = qg + (size_t)s0n * 1024 + (2 * it + sub) * 64;                                     \
                    const bf16_t* tb_ = kTg + (size_t)((2 * it + sub) * 64) * S + s0n;                                     \
                    rq0 = *(const uint4*)(qb_ + offq0); rq1 = *(const uint4*)(qb_ + offq1);                                \
                    rt0 = *(const uint4*)(tb_ + offt0); rt1 = *(const uint4*)(tb_ + offt1);                                \
                }                                                                                                          \
                if (it == 0) {                                                                                             \
                    if (has_next && sub == 0) { const bf16_t* vb_ = vTg + s0n; rv0 = *(const uint4*)(vb_ + offt0); rv1 = *(const uint4*)(vb_ + offt1); } \
                } else {                                                                                                   \
                    if (sub == 0) { const uint4* sp_ = (const uint4*)(sg + (size_t)(s0 >> 6) * 16384 + (unsigned)(launder(t8) * 16)); rs0 = sp_[0]; rs1 = sp_[1]; } \
                }                                                                                                          \
                _Pragma("unroll") for (int ks = 0; ks < 4; ++ks) {                                                         \
                    const bf16x8 qf = *(const bf16x8*)(QS + (jb * 32 + l31) * LS + ks * 16 + lh * 8);                      \
                    const bf16x8 cf = *(const bf16x8*)(CL + (eb * 32 + l31) * LS + ks * 16 + lh * 8);                      \
                    iacc = MFMA32(cf, qf, iacc);                                                                           \
                }                                                                                                          \
                __builtin_amdgcn_sched_barrier(0);                                                                         \
                {                                                                                                          \
                    const int jj = t8 >> 2, part = t8 & 3;                                                                 \
                    {                                                                                                      \
                        const uint4 q0 = *(const uint4*)(QS + jj * LS + part * 16), q1 = *(const uint4*)(QS + jj * LS + part * 16 + 8); \
                        const uint4 n0 = *(const uint4*)(nbo + dc * 64 + part * 16), n1 = *(const uint4*)(nbo + dc * 64 + part * 16 + 8); \
                        nqp = DOT2(q0.x, n0.x, nqp); nqp = DOT2(q0.y, n0.y, nqp); nqp = DOT2(q0.z, n0.z, nqp); nqp = DOT2(q0.w, n0.w, nqp); \
                        nqp = DOT2(q1.x, n1.x, nqp); nqp = DOT2(q1.y, n1.y, nqp); nqp = DOT2(q1.z, n1.z, nqp); nqp = DOT2(q1.w, n1.w, nqp); \
                    }                                                                                                      \
                    {                                                                                                      \
                        const uint4 q0 = *(const uint4*)(KT + jj * LS + part * 16), q1 = *(const uint4*)(KT + jj * LS + part * 16 + 8); \
                        const unsigned one2 = 0x3f803f80u;                                                                 \
                        float acc_n = DOT2(q0.x, one2, 0.f); acc_n = DOT2(q0.y, one2, acc_n); acc_n = DOT2(q0.z, one2, acc_n); acc_n = DOT2(q0.w, one2, acc_n); \
                        acc_n = DOT2(q1.x, one2, acc_n); acc_n = DOT2(q1.y, one2, acc_n); acc_n = DOT2(q1.z, one2, acc_n); acc_n = DOT2(q1.w, one2, acc_n); \
                        acc_n += dpp_xor1(acc_n); acc_n += dpp_xor2(acc_n);                                                \
                        if (part == 0) { const float nn = decay * nvo[dc * 64 + jj] + acc_n; nvn[dc * 64 + jj] = nn; nbn[dc * 64 + jj] = f2bf(nn); } \
                    }                                                                                                      \
                }                                                                                                          \
                __builtin_amdgcn_sched_barrier(0);                                                                         \
                _Pragma("unroll") for (int i = 0; i < 16; ++i) CT[i] *= decay;                                             \
                _Pragma("unroll") for (int ks = 0; ks < 4; ++ks) {                                                         \
                    const bf16x8 af = *(const bf16x8*)(KT + (db * 32 + l31) * LS + ks * 16 + lh * 8);                      \
                    const bf16x8 bf = *(const bf16x8*)(VTU + (eb * 32 + l31) * LS + ks * 16 + lh * 8);                     \
                    CT = MFMA32(af, bf, CT);                                                                               \
                }                                                                                                          \
            }
            MLSTM_IT(0, ct0, rqX0, rqX1, rtX0, rtX1) MLSTM_IT(1, ct1, rqY0, rqY1, rtY0, rtY1)
#undef MLSTM_IT
            nqp += dpp_xor1(nqp); nqp += dpp_xor2(nqp);
            if ((t8 & 3) == 0) TNQ[sub * 64 + (t8 >> 2)] = nqp;
            const int jr = jb * 32 + l31;
            if (sub == 1) {
#pragma unroll
                for (int i = 0; i < 16; ++i) IX[(w * 16 + i) * 64 + lane] = iacc[i];
            } else {
                const float Mq = TM[jr];
                const int jrl = launder(jr);
                float rowsum = 0.f;
                const unsigned sw[8] = {rs0.x, rs0.y, rs0.z, rs0.w, rs1.x, rs1.y, rs1.z, rs1.w};
#pragma unroll
                for (int g4 = 0; g4 < 4; ++g4) {
                    const int sr0 = eb * 32 + 8 * g4 + 4 * lh;
                    const float4 ta = *(const float4*)(TA + sr0);
                    const float tav[4] = {ta.x, ta.y, ta.z, ta.w};
                    float pv[4];
#pragma unroll
                    for (int q = 0; q < 4; ++q) {
                        const int sr = sr0 + q;
                        const bool ok = dir ? (sr >= jrl) : (sr <= jrl);
                        const unsigned swv = sw[2 * g4 + (q >> 1)];
                        const float sv = (q & 1) ? BHI(swv) : BLO(swv);
                        pv[q] = ok ? sv * __expf(tav[q] - Mq) : 0.f;
                        rowsum += pv[q];
                    }
                    u32x2 pk; pk[0] = pack2(pv[0], pv[1]); pk[1] = pack2(pv[2], pv[3]);
                    *(u32x2*)(PL + jr * LS + sr0) = pk;
                }
                rowsum += bperm(rowsum, launder(lane) ^ 32);
                if (lh == 0) TRS[eb * 64 + jr] = rowsum;
            }
            __syncthreads();
            if (sub == 0) {
                const float wiq = TWI[jr], elq = TEL[jr], nq = TNQ[jr] + TNQ[64 + jr];
                const float rowsum = TRS[jr] + TRS[64 + jr];
#pragma unroll
                for (int i = 0; i < 16; ++i) iacc[i] = (iacc[i] + IX[(w * 16 + i) * 64 + lane]) * wiq;
#pragma unroll
                for (int kst = 0; kst < 4; ++kst) {
                    const bf16x8 vf = *(const bf16x8*)(VTU + (eb * 32 + l31) * LS + kst * 16 + lh * 8);
                    const bf16x8 pf = *(const bf16x8*)(PL + jr * LS + kst * 16 + lh * 8);
                    iacc = MFMA32(vf, pf, iacc);
                }
                const float den = wiq * nq + rowsum;
                const float inv = 1.0f / fmaxf(fabsf(den), elq);
                bf16_t* dst = hout + (tokseq + s0) * 4096 + dir * 1024 + hd * 256 + es * 64 + (unsigned)(jr * 4096 + eb * 32);
#pragma unroll
                for (int g4 = 0; g4 < 4; ++g4) {
                    u32x2 pk;
                    pk[0] = pack2(iacc[4 * g4] * inv, iacc[4 * g4 + 1] * inv); pk[1] = pack2(iacc[4 * g4 + 2] * inv, iacc[4 * g4 + 3] * inv);
                    *(u32x2*)(dst + 8 * g4 + 4 * lh) = pk;
                }
            }
            mst = mnew;
        }
    }
    __syncthreads();
}

DI void gatecomb_phase(bf16_t* __restrict__ z1, const float* __restrict__ hn, int gtok, int vb, int vg, HB& hb) {
    const int tid = launder(TID256(hb)); const int lane = tid & 63, w = tid >> 6;
    for (int tok = vb * 4 + w; tok < gtok; tok += vg * 4) {
        bf16_t* base = z1 + (size_t)tok * 4096 + lane * 4;
        uint2 a[4], b[4], o[4];
#pragma unroll
        for (int hd = 0; hd < 4; ++hd) { a[hd] = *(const uint2*)(base + hd * 256); b[hd] = *(const uint2*)(base + 1024 + hd * 256); o[hd] = *(const uint2*)(base + 3072 + hd * 256); }
        float h[4][4], ss[4];
#pragma unroll
        for (int hd = 0; hd < 4; ++hd) {
            h[hd][0] = BLO(a[hd].x) + BLO(b[hd].x); h[hd][1] = BHI(a[hd].x) + BHI(b[hd].x);
            h[hd][2] = BLO(a[hd].y) + BLO(b[hd].y); h[hd][3] = BHI(a[hd].y) + BHI(b[hd].y);
            ss[hd] = h[hd][0] * h[hd][0] + h[hd][1] * h[hd][1] + h[hd][2] * h[hd][2] + h[hd][3] * h[hd][3];
        }
#pragma unroll
        for (int off = 1; off < 64; off <<= 1) {
#pragma unroll
            for (int hd = 0; hd < 4; ++hd) ss[hd] += xshfl(ss[hd], off);
        }
#pragma unroll
        for (int hd = 0; hd < 4; ++hd) {
            const float r = rsqrtf(ss[hd] * (1.0f / 256.0f) + EPS);
            const float4 gv = *(const float4*)(hn + hd * 256 + lane * 4);
            const float gn[4] = {gv.x, gv.y, gv.z, gv.w};
            const float ov[4] = {BLO(o[hd].x), BHI(o[hd].x), BLO(o[hd].y), BHI(o[hd].y)};
            float y[4];
#pragma unroll
            for (int e = 0; e < 4; ++e) y[e] = h[hd][e] * r * gn[e] * __builtin_amdgcn_rcpf(1.0f + __builtin_amdgcn_exp2f(-1.4426950408889634f * ov[e]));
            *(uint2*)(base + 3072 + hd * 256) = make_uint2(pack2(y[0], y[1]), pack2(y[2], y[3]));
        }
    }
}

DI void gsync(unsigned* ctr, unsigned& tgt, int wv8) {
    asm volatile("s_waitcnt vmcnt(0) lgkmcnt(0)" ::: "memory");
    __syncthreads();
    tgt += gridDim.x;
    if (wv8 == 0 && lane_id() == 0) {
        __builtin_amdgcn_fence(__ATOMIC_RELEASE, "agent");
        __hip_atomic_fetch_add(ctr, 1u, __ATOMIC_RELAXED, __HIP_MEMORY_SCOPE_AGENT);
        while (__hip_atomic_load(ctr, __ATOMIC_RELAXED, __HIP_MEMORY_SCOPE_AGENT) < tgt) __builtin_amdgcn_s_sleep(2);
        __builtin_amdgcn_fence(__ATOMIC_ACQUIRE, "agent");
    }
    __syncthreads();
}
template <class Epi>
DI void run_gemm(LAS unsigned char* lds, int wv8, const bf16_t* A, int lda, const bf16_t* Bt, int M, int N, int K, const Epi& e) {
    pg8::Gemm g; g.A = A; g.Bt = Bt; g.M = M; g.N = N; g.K = K; g.lda = lda;
    pg8::StaticOrder so; so.init(M, N, (int)gridDim.x, (int)blockIdx.x);
    pg8::gemm_phase<Epi, pg8::StaticOrder, true, true>(lds, g, so, e, wv8);
}

__global__ void __launch_bounds__(512, 2) mega(Params p) {
    cg::grid_group grid = cg::this_grid();
    extern __shared__ __attribute__((aligned(16))) unsigned char lds_[];
    LAS unsigned char* lds = (LAS unsigned char*)lds_;
    const int wv8 = __builtin_amdgcn_readfirstlane((int)(threadIdx.x >> 6));
    const int half = wv8 >> 2;
    char* smem = (char*)lds_ + half * SMEM_BYTES;
    HB hb; hb.cnt = (LAS unsigned*)(lds + 2 * SMEM_BYTES + half * 128); hb.ep = 0; hb.wv = wv8;
    if ((wv8 & 3) == 0 && lane_id() == 0) *hb.cnt = 0;
    __syncthreads();
    const int vb = (int)blockIdx.x * 2 + half, vg = (int)gridDim.x * 2;
    unsigned char* ws = p.ws;
    bf16_t* xb = (bf16_t*)(ws + WS_XB);
    float* ssq = (float*)(ws + WS_SSQ);
    for (int l = 0; l < 2; ++l) {
        prep_transpose<1>(p.ffn1_w_in + (size_t)l * D * 2 * DFF, p.ffn1_norm + l * D, (bf16_t*)(ws + WS_FFN_WIN + (l * 2 + 0) * SZ_WIN), D, 2 * DFF, 88, smem, vb, vg, hb);
        prep_transpose<1>(p.ffn2_w_in + (size_t)l * D * 2 * DFF, p.ffn2_norm + l * D, (bf16_t*)(ws + WS_FFN_WIN + (l * 2 + 1) * SZ_WIN), D, 2 * DFF, 88, smem, vb, vg, hb);
        prep_transpose<0>(p.ffn1_w_out + (size_t)l * DFF * D, nullptr, (bf16_t*)(ws + WS_FFN_WOUT + (l * 2 + 0) * SZ_WOUT), DFF, D, 16, smem, vb, vg, hb);
        prep_transpose<0>(p.ffn2_w_out + (size_t)l * DFF * D, nullptr, (bf16_t*)(ws + WS_FFN_WOUT + (l * 2 + 1) * SZ_WOUT), DFF, D, 16, smem, vb, vg, hb);
    }
    prep_transpose<2>(p.ab_w_in, p.mix_norm, (bf16_t*)(ws + WS_AB_IN), D, 1536, 28, smem, vb, vg, hb);
    prep_fourier_w(p.ab_w_in, p.mix_norm, (bf16_t*)(ws + WS_AB_IN), smem, vb, vg, hb);
    prep_transpose<0>(p.ab_w_out, nullptr, (bf16_t*)(ws + WS_AB_OUT), D, D, 16, smem, vb, vg, hb);
    prep_transpose<0>(p.c_w_in, p.mix_norm + D, (bf16_t*)(ws + WS_C_IN), D, 4112, 68, smem, vb, vg, hb);
    prep_transpose<0>(p.c_w_out, nullptr, (bf16_t*)(ws + WS_C_OUT), D, D, 16, smem, vb, vg, hb);
    prep_tables(ws, vb, vg, hb);
    {
        const int lane = lane_id(), wv = wv8;
        for (int row = (int)blockIdx.x * 8 + wv; row < MTOK; row += (int)gridDim.x * 8) {
            const float* src = (row < MP ? p.x_in[0] + (size_t)row * D : p.x_in[1] + (size_t)(row - MP) * D);
            bf16_t* dst = xb + (size_t)row * D;
            float sq = 0.f;
#pragma unroll
            for (int i = 0; i < 4; ++i) {
                const float4 v = *(const float4*)(src + i * 256 + lane * 4);
                *(uint2*)(dst + i * 256 + lane * 4) = make_uint2(pack2(v.x, v.y), pack2(v.z, v.w));
                sq += (v.x * v.x + v.y * v.y) + (v.z * v.z + v.w * v.w);
            }
#pragma unroll
            for (int off = 1; off < 64; off <<= 1) sq += xshfl(sq, off);
            if (lane < 4) ssq[(size_t)row * SSQW + lane] = (lane == 0) ? sq : 0.f;
        }
    }
    grid.sync();
    unsigned* gbar = (unsigned*)(ws + WS_BAR); unsigned gtgt = 0;
    bf16_t* hid = (bf16_t*)(ws + WS_BIG);
    for (int l = 0; l < 2; ++l) {
        for (int which = 0; which < 2; ++which) {
            const bf16_t* win = (const bf16_t*)(ws + WS_FFN_WIN + (l * 2 + which) * SZ_WIN);
            const bf16_t* wout = (const bf16_t*)(ws + WS_FFN_WOUT + (l * 2 + which) * SZ_WOUT);
            const bool last_ffn = (l == 1 && which == 1);
            if (!last_ffn) {
                bf16_t* hid1 = (bf16_t*)p.out;
                EpiSwiglu e1; e1.H = hid; e1.H1 = hid1; e1.ssq = ssq;
                run_gemm(lds, hb.wv, xb, D, win, MTOK, 2 * DFF, D, e1);
                gsync(gbar, gtgt, wv8);
                for (int hh = 0; hh < 2; ++hh) {
                    const int h = 1 - hh;
                    const size_t toff = (size_t)h * MP * D;
                    EpiResid e2; e2.xs = (LAS float*)(lds + 131072); e2.XR = (l == 0 && which == 0) ? p.x_in[h] : nullptr;
                    e2.XO = nullptr; e2.XB = xb + toff; e2.ssq = ssq + (size_t)h * MP * SSQW; e2.alpha = 0.5f;
                    run_gemm(lds, hb.wv, h == 0 ? hid : hid1, DFF, wout, MP, D, DFF, e2);
                }
                gsync(gbar, gtgt, wv8);
            } else {
                for (int h = 0; h < 2; ++h) {
                    const size_t toff = (size_t)h * MP * D;
                    EpiSwiglu e1; e1.H = hid; e1.H1 = hid; e1.ssq = ssq + (size_t)h * MP * SSQW;
                    run_gemm(lds, hb.wv, xb + toff, D, win, MP, 2 * DFF, D, e1);
                    gsync(gbar, gtgt, wv8);
                    EpiResid e2; e2.xs = (LAS float*)(lds + 131072); e2.XR = nullptr;
                    e2.XO = p.out + toff; e2.XB = xb + toff; e2.ssq = ssq + (size_t)h * MP * SSQW; e2.alpha = 0.5f;
                    run_gemm(lds, hb.wv, hid, DFF, wout, MP, D, DFF, e2);
                    gsync(gbar, gtgt, wv8);
                }
            }
            if (which == 1) continue;
            if (l == 0) {
                bf16_t* z0 = (bf16_t*)(ws + WS_BIG);
                bf16_t* vt = (bf16_t*)(ws + WS_BIG + 512 * MiB);
                EpiZ0 ez; ez.Z = z0; ez.ssq = ssq;
                run_gemm(lds, hb.wv, xb, D, (const bf16_t*)(ws + WS_AB_IN), MTOK, ABN, D, ez);
                gsync(gbar, gtgt, wv8);
                qkprep_phase(z0, vt, p.ab_q_norm, p.ab_k_norm, (const float2*)(ws + WS_ROPE), smem, vb, vg, hb);
                fourier_stage1<64>(z0, 0, 16, (const bf16_t*)(ws + WS_W1_64), smem, vb, vg, hb);
                fourier_stage1<128>(z0, MP, 8, (const bf16_t*)(ws + WS_W1_128), smem, vb, vg, hb);
                gsync(gbar, gtgt, wv8);
                attn_phase(z0, vt, p.ab_q_norm, p.ab_k_norm, (char*)lds_, wv8);
                fourier_stage2(z0, 0, 16, 64, (const bf16_t*)(ws + WS_W2_64), smem, vb, vg, hb);
                fourier_stage2(z0, MP, 8, 128, (const bf16_t*)(ws + WS_W2_64), smem, vb, vg, hb);
                gsync(gbar, gtgt, wv8);
                EpiResid eo; eo.xs = (LAS float*)(lds + 131072); eo.XR = nullptr; eo.XO = nullptr; eo.XB = xb; eo.ssq = ssq; eo.alpha = 1.0f;
                run_gemm(lds, hb.wv, z0, ZW, (const bf16_t*)(ws + WS_AB_OUT), MTOK, D, D, eo);
                gsync(gbar, gtgt, wv8);
            } else {
                bf16_t* z1 = (bf16_t*)p.out;
                bf16_t* qc = (bf16_t*)(ws + WS_BIG);
                bf16_t* kTb = (bf16_t*)(ws + WS_BIG + 128 * MiB);
                bf16_t* vTb = (bf16_t*)(ws + WS_BIG + 256 * MiB);
                bf16_t* sfr = (bf16_t*)(ws + WS_BIG + 384 * MiB);
                float4* gsc = (float4*)(ws + WS_BIG + 416 * MiB);
                float* gates = (float*)(ws + WS_BIG + 424 * MiB);
                for (int g = 0; g < 2; ++g) {
                    const int S = g == 0 ? 4096 : 8192, gtok = MP, nseq = gtok / S;
                    const size_t tok0 = (size_t)g * MP;
                    const size_t toff = tok0 * D;
                    EpiZ1 ez; ez.Z = z1; ez.G = gates; ez.bias = p.c_gate_bias; ez.ssq = ssq + tok0 * SSQW;
                    run_gemm(lds, hb.wv, xb + toff, D, (const bf16_t*)(ws + WS_C_IN), gtok, CN, D, ez);
                    gsync(gbar, gtgt, wv8);
                    conv_phase(z1, qc, kTb, vTb, sfr, gates, gsc, p.c_conv, S, gtok, smem, vb, vg, hb);
                    gsync(gbar, gtgt, wv8);
                    mlstm_phase(qc, kTb, vTb, sfr, gsc, z1, S, nseq, (char*)lds_, wv8);
                    gsync(gbar, gtgt, wv8);
                    gatecomb_phase(z1, p.c_head_norm, gtok, vb, vg, hb);
                    gsync(gbar, gtgt, wv8);
                    EpiResid eo; eo.xs = (LAS float*)(lds + 131072); eo.XR = nullptr; eo.XO = nullptr; eo.XB = xb + toff; eo.ssq = ssq + tok0 * SSQW; eo.alpha = 1.0f;
                    run_gemm(lds, hb.wv, z1 + 3072, 4096, (const bf16_t*)(ws + WS_C_OUT), gtok, D, D, eo);
                    gsync(gbar, gtgt, wv8);
                }
            }
        }
    }
}

extern "C" void kernel_launch(void* const* d_in, const int* in_sizes, int n_in, void* d_out, int out_size, void* d_ws, size_t ws_size, hipStream_t stream) {
    static int grid_blocks = 0;
    if (!grid_blocks) {
        int dev = 0, cus = 0, per_cu = 0;
        (void)hipGetDevice(&dev);
        (void)hipDeviceGetAttribute(&cus, hipDeviceAttributeMultiprocessorCount, dev);
        if (hipFuncSetAttribute((const void*)mega, hipFuncAttributeMaxDynamicSharedMemorySize, LDS_BYTES) != hipSuccess) fprintf(stderr, "kernel_launch: hipFuncSetAttribute(%d B LDS) failed\n", LDS_BYTES);
        (void)hipOccupancyMaxActiveBlocksPerMultiprocessor(&per_cu, (const void*)mega, 512, LDS_BYTES);
        if (per_cu < 1) fprintf(stderr, "kernel_launch: occupancy query says %d blocks per CU\n", per_cu);
        (void)hipGetLastError();
        grid_blocks = cus;
        if (ws_size < (size_t)1024 * MiB) fprintf(stderr, "kernel_launch: ws_size %zu smaller than expected 1 GiB\n", ws_size);
    }
    Params p{};
    p.x_in[0] = (const float*)d_in[0]; p.x_in[1] = (const float*)d_in[1];
    p.ffn1_norm = (const float*)d_in[2]; p.ffn1_w_in = (const float*)d_in[3]; p.ffn1_w_out = (const float*)d_in[4];
    p.mix_norm = (const float*)d_in[5]; p.ab_w_in = (const float*)d_in[6]; p.ab_q_norm = (const float*)d_in[7];
    p.ab_k_norm = (const float*)d_in[8]; p.ab_w_out = (const float*)d_in[9]; p.c_w_in = (const float*)d_in[10];
    p.c_gate_bias = (const float*)d_in[11]; p.c_conv = (const float*)d_in[12]; p.c_head_norm = (const float*)d_in[13];
    p.c_w_out = (const float*)d_in[14]; p.ffn2_norm = (const float*)d_in[15]; p.ffn2_w_in = (const float*)d_in[16];
    p.ffn2_w_out = (const float*)d_in[17];
    p.out = (float*)d_out; p.ws = (unsigned char*)d_ws;
    (void)hipMemsetAsync((unsigned char*)d_ws + WS_BAR, 0, 256, stream);
    void* args[] = {&p};
    hipError_t e = hipLaunchCooperativeKernel((const void*)mega, dim3(grid_blocks), dim3(512), args, LDS_BYTES, stream);
    if (e != hipSuccess) fprintf(stderr, "cooperative launch failed: %s (grid %d)\n", hipGetErrorString(e), grid_blocks);
}
```

```cpp
#include <hip/hip_runtime.h>
#include <hip/hip_cooperative_groups.h>
#include <cstdio>
#include <cstdint>
namespace cg = cooperative_groups;

typedef unsigned short bf16_t;
typedef short bf16x8 __attribute__((ext_vector_type(8)));
typedef short s16x4 __attribute__((ext_vector_type(4)));
typedef float f32x16 __attribute__((ext_vector_type(16)));
typedef float f32x4 __attribute__((ext_vector_type(4)));
#define DI __device__ __forceinline__
#define MFMA32(a, b, c) __builtin_amdgcn_mfma_f32_32x32x16_bf16((a), (b), (c), 0, 0, 0)

constexpr int D = 1024, DFF = 2816;
constexpr int MTOK = 131072;
constexpr int MP = 65536;
constexpr float EPS = 1e-6f;
constexpr int ZW = 2048;
constexpr int ABN = 1792;
constexpr int CN = 4352;

constexpr size_t MiB = 1024 * 1024;
constexpr size_t SZ_WIN = (size_t)2 * DFF * D * 2, SZ_WOUT = (size_t)D * DFF * 2;
constexpr size_t WS_FFN_WIN = 0;
constexpr size_t WS_FFN_WOUT = WS_FFN_WIN + 4 * SZ_WIN;
constexpr size_t WS_AB_IN = WS_FFN_WOUT + 4 * SZ_WOUT;
constexpr size_t WS_AB_OUT = WS_AB_IN + (size_t)ABN * D * 2;
constexpr size_t WS_C_IN = WS_AB_OUT + (size_t)D * D * 2;
constexpr size_t WS_C_OUT = WS_C_IN + (size_t)CN * D * 2;
constexpr size_t WS_W_END = WS_C_OUT + (size_t)D * D * 2;
static_assert(WS_W_END <= 84 * MiB, "weights");
constexpr size_t WS_GATES = 92 * MiB;
constexpr size_t WS_SSQ = 84 * MiB;
constexpr size_t WS_ROPE = 94 * MiB;
constexpr size_t WS_W1_64 = WS_ROPE + 65536;
constexpr size_t WS_W1_128 = WS_W1_64 + 32768;
constexpr size_t WS_W2_64 = WS_W1_128 + 131072;
constexpr size_t WS_BAR = 95 * MiB;
constexpr size_t WS_XB = 96 * MiB;
constexpr size_t WS_BIG = 352 * MiB;

constexpr int SMEM_BYTES = 4 * 128 * 72 * 2 + 1024;
constexpr int LDS_BYTES = 2 * SMEM_BYTES + 256;
constexpr int GTOK = 32768;

struct Params {
    const float* x_in[2];
    const float *ffn1_norm, *ffn1_w_in, *ffn1_w_out, *mix_norm, *ab_w_in, *ab_q_norm, *ab_k_norm, *ab_w_out;
    const float *c_w_in, *c_gate_bias, *c_conv, *c_head_norm, *c_w_out, *ffn2_norm, *ffn2_w_in, *ffn2_w_out;
    float* out;
    unsigned char* ws;
};

DI int launder(int x) { asm volatile("" : "+v"(x)); return x; }
#define DOT2(a, b, c) __builtin_amdgcn_fdot2_f32_bf16(__builtin_bit_cast(bf2_t, (unsigned)(a)), __builtin_bit_cast(bf2_t, (unsigned)(b)), (c), false)
DI float bperm(float v, int srclane) { return __int_as_float(__builtin_amdgcn_ds_bpermute(srclane << 2, __float_as_int(v))); }
DI float dpp_xor1(float v) { return __int_as_float(__builtin_amdgcn_update_dpp(0, __float_as_int(v), 0xB1, 0xf, 0xf, false)); }
DI float dpp_xor2(float v) { return __int_as_float(__builtin_amdgcn_update_dpp(0, __float_as_int(v), 0x4E, 0xf, 0xf, false)); }
DI float rdlane(float v, int l) { return __int_as_float(__builtin_amdgcn_readlane(__float_as_int(v), l)); }
DI int lane_id() { int l; asm volatile("v_mbcnt_lo_u32_b32 %0, -1, 0\n\tv_mbcnt_hi_u32_b32 %0, -1, %0" : "=v"(l)); return l; }
DI float xshfl(float v, int m) { const int l = launder(lane_id()); return bperm(v, l ^ m); }
DI float bf2f(bf16_t v) { return __uint_as_float(((unsigned)v) << 16); }
typedef __bf16 bf2_t __attribute__((ext_vector_type(2)));
typedef float f32x2 __attribute__((ext_vector_type(2)));
typedef unsigned u32x4 __attribute__((ext_vector_type(4)));
typedef unsigned u32x2 __attribute__((ext_vector_type(2)));
DI unsigned pack2(float lo, float hi) { f32x2 v = {lo, hi}; return __builtin_bit_cast(unsigned, __builtin_convertvector(v, bf2_t)); }
DI bf16_t f2bf(float f) { return (bf16_t)(pack2(f, 0.f) & 0xffffu); }

#define LAS __attribute__((address_space(3)))
struct HB { LAS unsigned* cnt; unsigned ep; int wv; };
#define TID256(hb) ((((hb).wv & 3) << 6) | lane_id())
DI void hb_sync(HB& hb) {
    __builtin_amdgcn_fence(__ATOMIC_RELEASE, "workgroup");
    hb.ep += 4;
    if (lane_id() == 0) __hip_atomic_fetch_add(hb.cnt, 1u, __ATOMIC_RELAXED, __HIP_MEMORY_SCOPE_WORKGROUP);
    while (__hip_atomic_load(hb.cnt, __ATOMIC_RELAXED, __HIP_MEMORY_SCOPE_WORKGROUP) < hb.ep) __builtin_amdgcn_s_sleep(1);
    __builtin_amdgcn_fence(__ATOMIC_ACQUIRE, "workgroup");
}
template <int MODE>
DI void prep_transpose(const float* __restrict__ W, const float* __restrict__ g, bf16_t* __restrict__ dst, int K, int Nsrc, int nOB, char* smem, int vb, int vg, HB& hb) {
    float* tile = (float*)smem;
    const int nKB = K >> 6, total = nKB * nOB, tid = launder(TID256(hb));
    for (int u = vb; u < total; u += vg) {
        const int kb = u % nKB, ob = u / nKB;
        int srccol;
        if (MODE == 0) srccol = ob * 64;
        else if (MODE == 1) srccol = ((ob & 2) ? DFF : 0) + (ob >> 2) * 128 + (ob & 1) * 64;
        else { if (ob >= 12 && ob < 20) continue; srccol = ob < 12 ? 256 + ob * 64 : 1024 + (ob - 20) * 64; }
        const int c = tid & 63, r0 = tid >> 6;
        hb_sync(hb);
#pragma unroll
        for (int i = 0; i < 16; ++i) {
            const int k = r0 + 4 * i, kk = kb * 64 + k;
            float v = (srccol + c < Nsrc) ? W[(size_t)kk * Nsrc + srccol + c] : 0.f;
            if (g) v *= g[kk];
            tile[k * 65 + c] = v;
        }
        hb_sync(hb);
        const int n = tid >> 2, k0 = (tid & 3) * 16;
        unsigned o[8];
#pragma unroll
        for (int j = 0; j < 8; ++j) o[j] = pack2(tile[(k0 + 2 * j) * 65 + n], tile[(k0 + 2 * j + 1) * 65 + n]);
        uint4* dp = (uint4*)(dst + (size_t)(ob * 64 + n) * K + kb * 64 + k0);
        dp[0] = make_uint4(o[0], o[1], o[2], o[3]);
        dp[1] = make_uint4(o[4], o[5], o[6], o[7]);
    }
}

DI void prep_fourier_w(const float* __restrict__ W  , const float* __restrict__ gam, bf16_t* __restrict__ dst, char* smem, int vb, int vg, HB& hb) {
    float* tile = (float*)smem;
    float* ct = tile + 64 * 65;
    float* st = ct + 64;
    const int tid = launder(TID256(hb));
    for (int u = vb; u < 16 * 4; u += vg) {
        const int kb = u & 15, g = u >> 4;
        hb_sync(hb);
        if (tid < 64) { float s, c; sincospif((float)tid / 32.0f, &s, &c); ct[tid] = c * 0.125f; st[tid] = -s * 0.125f; }
        const int c = tid & 63, r0 = tid >> 6;
#pragma unroll
        for (int i = 0; i < 16; ++i) { const int k = r0 + 4 * i, kk = kb * 64 + k; tile[k * 65 + c] = W[(size_t)kk * 1536 + g * 64 + c] * gam[kk]; }
        hb_sync(hb);
        const int cp = tid >> 2, k0 = (tid & 3) * 16;
        float a[16], b[16];
#pragma unroll
        for (int j = 0; j < 16; ++j) { a[j] = 0.f; b[j] = 0.f; }
        for (int cc = 0; cc < 64; ++cc) {
            const int ph = (cc * cp) & 63; const float cv = ct[ph], sv = st[ph];
#pragma unroll
            for (int j = 0; j < 16; ++j) { const float w = tile[(k0 + j) * 65 + cc]; a[j] += w * cv; b[j] += w * sv; }
        }
        unsigned oa[8], ob[8];
#pragma unroll
        for (int j = 0; j < 8; ++j) { oa[j] = pack2(a[2 * j], a[2 * j + 1]); ob[j] = pack2(b[2 * j], b[2 * j + 1]); }
        uint4* pa = (uint4*)(dst + (size_t)(768 + g * 64 + cp) * 1024 + kb * 64 + k0);
        uint4* pb = (uint4*)(dst + (size_t)(1024 + g * 64 + cp) * 1024 + kb * 64 + k0);
        pa[0] = make_uint4(oa[0], oa[1], oa[2], oa[3]); pa[1] = make_uint4(oa[4], oa[5], oa[6], oa[7]);
        pb[0] = make_uint4(ob[0], ob[1], ob[2], ob[3]); pb[1] = make_uint4(ob[4], ob[5], ob[6], ob[7]);
    }
}


DI int acc_row(int i, int lh) { return (i & 3) + 8 * (i >> 2) + 4 * lh; }

namespace pg8 {
#define PG8_LAS __attribute__((address_space(3)))
constexpr int BM = 256, BK = 64, HALF = 128, HTB = HALF * BK * 2, STAGE_BYTES = 8 * HTB, NXCD = 8, WGM = 8;
__host__ __device__ __forceinline__ int lds_byte(int r, int c) { const int st = (r >> 4) * 2 + (c >> 5), rr = r & 15, cc = c & 31, ob = rr * 64 + cc * 2; return st * 1024 + (ob ^ (((ob >> 9) & 1) << 5)); }
__host__ __device__ __forceinline__ void stage_rc(int b, int& R, int& C) { const int st = b / 1024, sb = b % 1024, swz = sb ^ (((sb >> 9) & 1) << 5); R = (st >> 1) * 16 + swz / 64; C = (st & 1) * 32 + (swz % 64) / 2; }
__host__ __device__ __forceinline__ int perm32(int rho) { const int n = rho >> 4, i = rho & 15; return 8 * (i >> 2) + 4 * n + (i & 3); }
struct Unit { int pm, pn; };
struct Gemm { const bf16_t* A; const bf16_t* Bt; int M, N, K, lda; };
struct StaticOrder {
    int nM, nN, nwg, G, c;
    __host__ __device__ void init(int M, int N, int G_, int c_) { nM = M / BM; nN = N / BM; nwg = nM * nN; G = G_; c = c_; }
    __host__ __device__ bool next(int i, Unit& u) const {
        const long L = (long)i * G + c; if (L >= nwg) return false;
        int wgid = (int)L; { const int q = nwg / NXCD, r = nwg % NXCD, xcd = wgid % NXCD, off = wgid / NXCD; wgid = (xcd < r ? xcd * (q + 1) : r * (q + 1) + (xcd - r) * q) + off; }
        const int nig = WGM * nN, gid = wgid / nig, fm = gid * WGM, gsz = (nM - fm) < WGM ? (nM - fm) : WGM;
        u.pm = fm + ((wgid % nig) % gsz); u.pn = (wgid % nig) / gsz; return true;
    }
    __device__ __forceinline__ void a_ready(const Unit&) const {}
    __device__ __forceinline__ void done(const Unit&) const {}
};
template <class Epi, class Sched, bool ALIGN_EPI = false, bool SP2 = false>
__device__ __forceinline__ void gemm_phase(PG8_LAS unsigned char* lds, const Gemm g, const Sched& S, const Epi& E, int wv8) {
    const int tid = launder((wv8 << 6) | lane_id()), wid = __builtin_amdgcn_readfirstlane(tid >> 6), lane = tid & 63, wr = wid >> 2, wc = wid & 3, fr = lane & 15, fq = lane >> 4;
    const int K = g.K, nt = K / BK;
    unsigned voffA[2], voffB[2];
#pragma unroll
    for (int i = 0; i < 2; ++i) { int R, C; stage_rc(tid * 16 + i * 8192, R, C); const int Rb = Epi::PERM ? ((R & ~31) + perm32(R & 31)) : R;
        voffA[i] = (unsigned)(R * g.lda + C) * 2u; voffB[i] = (unsigned)(Rb * K + C) * 2u; }
    const size_t kstep = (size_t)(BK * 2);
    const size_t hstepA = (size_t)HALF * g.lda * 2, hstepB = (size_t)HALF * K * 2;
    const size_t tstepA = 2 * hstepA, tstepB = 2 * hstepB;
    const unsigned ldsw = (unsigned)wid * 1024u;
    const int aoff = lds_byte(wr * 64 + fr, fq * 8), boff = lds_byte(wc * 32 + fr, fq * 8);
#define PG8_SA(b, h) (((b) * 2 + (h)) * HTB)
#define PG8_SB(b, h) ((4 + (b) * 2 + (h)) * HTB)
#define PG8_STAGE(bufoff, gbase, voff) do { _Pragma("unroll") for (int _i = 0; _i < 2; ++_i) \
        __builtin_amdgcn_global_load_lds((const unsigned*)((const char*)(gbase) + (voff)[_i]), (PG8_LAS unsigned*)(lds + (bufoff) + ldsw + _i * 8192), 16, 0, 0); } while (0)
#define PG8_LDA(dst, b, h) do { _Pragma("unroll") for (int m = 0; m < 4; ++m) _Pragma("unroll") for (int k = 0; k < 2; ++k) dst[m][k] = *(const PG8_LAS bf16x8*)(lds + PG8_SA(b, h) + aoff + m * 2048 + k * 1024); } while (0)
#define PG8_LDB(dst, b, h) do { _Pragma("unroll") for (int n = 0; n < 2; ++n) _Pragma("unroll") for (int k = 0; k < 2; ++k) dst[n][k] = *(const PG8_LAS bf16x8*)(lds + PG8_SB(b, h) + boff + n * 2048 + k * 1024); } while (0)
#define PG8_MMA(ai, bj, At, Bt) do { __builtin_amdgcn_s_setprio(1); _Pragma("unroll") for (int m = 0; m < 4; ++m) _Pragma("unroll") for (int n = 0; n < 2; ++n) _Pragma("unroll") for (int k = 0; k < 2; ++k) \
        acc[ai][bj][m][n] = __builtin_amdgcn_mfma_f32_16x16x32_bf16(Bt[n][k], At[m][k], acc[ai][bj][m][n], 0, 0, 0); __builtin_amdgcn_s_setprio(0); } while (0)
#define PG8_WAIT_V(n) asm volatile("s_waitcnt vmcnt(" #n ")" ::: "memory")
#define PG8_WAIT_L(n) asm volatile("s_waitcnt lgkmcnt(" #n ")" ::: "memory")
#define PG8_BAR __builtin_amdgcn_s_barrier()
#define PG8_SCHED __builtin_amdgcn_sched_barrier(0)
    Unit cur, nxt; int ui = 0;
    if (!S.next(0, cur)) return;
    f32x4 acc[2][2][4][2];
#pragma unroll
    for (int a = 0; a < 2; ++a)
#pragma unroll
        for (int b = 0; b < 2; ++b)
#pragma unroll
            for (int m = 0; m < 4; ++m)
#pragma unroll
                for (int n = 0; n < 2; ++n) acc[a][b][m][n] = (f32x4){0.f, 0.f, 0.f, 0.f};
    bf16x8 At[4][2], B0[2][2], B1[2][2];
    const char* cA = (const char*)g.A + (size_t)cur.pm * tstepA; const char* cB = (const char*)g.Bt + (size_t)cur.pn * tstepB;
    S.a_ready(cur);
    if constexpr (SP2) {
        PG8_STAGE(PG8_SB(0, 0), cB, voffB); PG8_STAGE(PG8_SB(0, 1), cB + hstepB, voffB); PG8_STAGE(PG8_SA(0, 0), cA, voffA); PG8_STAGE(PG8_SA(0, 1), cA + hstepA, voffA);
        if (wr == 1) PG8_BAR;
        PG8_WAIT_V(2); PG8_BAR;
        PG8_STAGE(PG8_SB(1, 0), cB + kstep, voffB); PG8_STAGE(PG8_SA(1, 0), cA + kstep, voffA); PG8_STAGE(PG8_SB(1, 1), cB + hstepB + kstep, voffB);
        PG8_WAIT_V(6); PG8_BAR;
    } else {
        PG8_STAGE(PG8_SB(0, 0), cB, voffB); PG8_STAGE(PG8_SA(0, 0), cA, voffA); PG8_STAGE(PG8_SB(0, 1), cB + hstepB, voffB); PG8_STAGE(PG8_SA(0, 1), cA + hstepA, voffA);
        if (wr == 1) PG8_BAR;
        PG8_WAIT_V(4); PG8_BAR;
        PG8_STAGE(PG8_SB(1, 0), cB + kstep, voffB); PG8_STAGE(PG8_SA(1, 0), cA + kstep, voffA); PG8_STAGE(PG8_SB(1, 1), cB + hstepB + kstep, voffB);
        PG8_WAIT_V(6); PG8_BAR;
    }
    for (;;) {
        const bool has_next = S.next(ui + 1, nxt);
        const char* nA = has_next ? (const char*)g.A + (size_t)nxt.pm * tstepA : cA; const char* nB = has_next ? (const char*)g.Bt + (size_t)nxt.pn * tstepB : cB;
        for (int t = 0; t < nt; t += 2) {
            const bool last = (t == nt - 2);
            const char* a1 = cA + (size_t)(t + 1) * kstep;
            const char* a2 = last ? nA : cA + (size_t)(t + 2) * kstep; const char* b2 = last ? nB : cB + (size_t)(t + 2) * kstep;
            const char* a3 = a2 + kstep; const char* b3 = b2 + kstep;
            if (last && has_next) S.a_ready(nxt);
            if constexpr (SP2) {
            PG8_LDB(B0, 0, 0); PG8_LDB(B1, 0, 1); PG8_SCHED; PG8_LDA(At, 0, 0); PG8_STAGE(PG8_SA(1, 1), a1 + hstepA, voffA);
            PG8_WAIT_V(8); PG8_WAIT_L(0); PG8_BAR; PG8_MMA(0, 0, At, B0); PG8_MMA(0, 1, At, B1); PG8_BAR; PG8_SCHED;
            PG8_LDA(At, 0, 1); PG8_STAGE(PG8_SB(0, 0), b2, voffB); PG8_STAGE(PG8_SB(0, 1), b2 + hstepB, voffB); PG8_STAGE(PG8_SA(0, 0), a2, voffA);
            PG8_WAIT_V(8); PG8_WAIT_L(0); PG8_BAR; PG8_MMA(1, 0, At, B0); PG8_MMA(1, 1, At, B1); PG8_BAR; PG8_SCHED;
            PG8_LDB(B0, 1, 0); PG8_LDB(B1, 1, 1); PG8_SCHED; PG8_LDA(At, 1, 0); PG8_STAGE(PG8_SA(0, 1), a2 + hstepA, voffA);
            PG8_WAIT_V(8); PG8_WAIT_L(0); PG8_BAR; PG8_MMA(0, 0, At, B0); PG8_MMA(0, 1, At, B1); PG8_BAR; PG8_SCHED;
            PG8_LDA(At, 1, 1); PG8_STAGE(PG8_SB(1, 0), b3, voffB); PG8_STAGE(PG8_SB(1, 1), b3 + hstepB, voffB); PG8_STAGE(PG8_SA(1, 0), a3, voffA);
            PG8_WAIT_V(8); PG8_WAIT_L(0); PG8_BAR; PG8_MMA(1, 0, At, B0); PG8_MMA(1, 1, At, B1); PG8_BAR; PG8_SCHED;
            } else {
            PG8_LDB(B0, 0, 0); PG8_SCHED; PG8_LDA(At, 0, 0); PG8_STAGE(PG8_SA(1, 1), a1 + hstepA, voffA);
            PG8_WAIT_L(8); PG8_BAR; PG8_WAIT_L(0); PG8_MMA(0, 0, At, B0); PG8_BAR; PG8_SCHED;
            PG8_LDB(B1, 0, 1); PG8_STAGE(PG8_SB(0, 0), b2, voffB);
            PG8_BAR; PG8_WAIT_L(0); PG8_MMA(0, 1, At, B1); PG8_BAR;
            PG8_LDA(At, 0, 1); PG8_STAGE(PG8_SA(0, 0), a2, voffA);
            PG8_BAR; PG8_WAIT_L(0); PG8_MMA(1, 0, At, B0); PG8_BAR; PG8_SCHED;
            PG8_STAGE(PG8_SB(0, 1), b2 + hstepB, voffB);
            PG8_WAIT_V(6); PG8_BAR; PG8_MMA(1, 1, At, B1); PG8_BAR;
            PG8_LDB(B0, 1, 0); PG8_SCHED; PG8_LDA(At, 1, 0); PG8_STAGE(PG8_SA(0, 1), a2 + hstepA, voffA);
            PG8_WAIT_L(8); PG8_BAR; PG8_WAIT_L(0); PG8_MMA(0, 0, At, B0); PG8_BAR; PG8_SCHED;
            PG8_LDB(B1, 1, 1); PG8_STAGE(PG8_SB(1, 0), b3, voffB);
            PG8_BAR; PG8_WAIT_L(0); PG8_MMA(0, 1, At, B1); PG8_BAR;
            PG8_LDA(At, 1, 1); PG8_STAGE(PG8_SA(1, 0), a3, voffA);
            PG8_BAR; PG8_WAIT_L(0); PG8_MMA(1, 0, At, B0); PG8_BAR; PG8_SCHED;
            PG8_STAGE(PG8_SB(1, 1), b3 + hstepB, voffB);
            PG8_WAIT_V(6); PG8_BAR; PG8_MMA(1, 1, At, B1); PG8_BAR;
            }
        }
        if constexpr (ALIGN_EPI) { if (wr == 0) PG8_BAR; }
        if constexpr (!Epi::AFTER_DRAIN) { E(acc, cur, wr, wc, fr, fq); S.done(cur); }
        if (!has_next) break;
#pragma unroll
        for (int a = 0; a < 2; ++a)
#pragma unroll
            for (int b = 0; b < 2; ++b)
#pragma unroll
                for (int m = 0; m < 4; ++m)
#pragma unroll
                    for (int n = 0; n < 2; ++n) acc[a][b][m][n] = (f32x4){0.f, 0.f, 0.f, 0.f};
        cur = nxt; cA = nA; cB = nB; ++ui;
        if constexpr (ALIGN_EPI) { if (wr == 1) PG8_BAR; }
    }
    PG8_WAIT_V(0);
    if constexpr (!ALIGN_EPI) { if (wr == 0) PG8_BAR; }
    PG8_BAR;
    if constexpr (Epi::AFTER_DRAIN) { E.fused(acc, cur, wr, wc, fr, fq, lds, wid, lane); S.done(cur); }
#undef PG8_SA
#undef PG8_SB
#undef PG8_STAGE
#undef PG8_LDA
#undef PG8_LDB
#undef PG8_MMA
#undef PG8_WAIT_V
#undef PG8_WAIT_L
#undef PG8_BAR
#undef PG8_SCHED
}
}

constexpr int SSQW = 4;
DI float row_rstd(const float* __restrict__ ssq, int row) {
    const float4 a = *(const float4*)(ssq + (size_t)row * SSQW);
    return rsqrtf(((a.x + a.y) + (a.z + a.w)) * (1.0f / 1024.0f) + EPS);
}
struct EpiSwiglu {
    static constexpr bool PERM = true, AFTER_DRAIN = false;
    bf16_t* H; bf16_t* H1; const float* ssq;
    DI void operator()(const f32x4 (&acc)[2][2][4][2], const pg8::Unit& u, int wr, int wc, int fr, int fq) const {
        const int row0 = u.pm * 256 + wr * 64 + fr, col0 = u.pn * 128 + wc * 32 + 8 * fq;
        bf16_t* Hb = (u.pm * 256 < MP) ? H : H1 - (size_t)MP * DFF;
#pragma unroll
        for (int ai = 0; ai < 2; ++ai)
#pragma unroll
            for (int m = 0; m < 4; ++m) {
                const int row = row0 + ai * 128 + m * 16;
                const float r = row_rstd(ssq, row);
                float h[8];
#pragma unroll
                for (int n = 0; n < 2; ++n)
#pragma unroll
                    for (int j = 0; j < 4; ++j) {
                        const float g = acc[ai][0][m][n][j] * r, uu = acc[ai][1][m][n][j] * r;
                        h[4 * n + j] = g * __builtin_amdgcn_rcpf(1.0f + __builtin_amdgcn_exp2f(-1.4426950408889634f * g)) * uu;
                    }
                *(uint4*)(Hb + (size_t)row * DFF + col0) = make_uint4(pack2(h[0], h[1]), pack2(h[2], h[3]), pack2(h[4], h[5]), pack2(h[6], h[7]));
            }
    }
};
struct EpiResid {
    static constexpr bool PERM = true, AFTER_DRAIN = false;
    const float* XR; float* XO; bf16_t* XB; float* ssq; float alpha; LAS float* xs;
    DI void operator()(const f32x4 (&acc)[2][2][4][2], const pg8::Unit& u, int wr, int wc, int fr, int fq) const {
        const int row0 = u.pm * 256 + wr * 64 + fr, col0 = u.pn * 256 + wc * 32 + 8 * fq;
#pragma unroll
        for (int ai = 0; ai < 2; ++ai)
#pragma unroll
            for (int m = 0; m < 4; ++m) {
                const int row = row0 + ai * 128 + m * 16;
                float sq = 0.f;
#pragma unroll
                for (int bj = 0; bj < 2; ++bj) {
                    const size_t idx = (size_t)row * D + col0 + bj * 128;
                    float4 x0, x1;
                    if (XR) { x0 = *(const float4*)(XR + idx); x1 = *(const float4*)(XR + idx + 4); }
                    else {
                        const uint4 xv = *(const uint4*)(XB + idx);
                        x0 = make_float4(__uint_as_float(xv.x << 16), __uint_as_float(xv.x & 0xffff0000u), __uint_as_float(xv.y << 16), __uint_as_float(xv.y & 0xffff0000u));
                        x1 = make_float4(__uint_as_float(xv.z << 16), __uint_as_float(xv.z & 0xffff0000u), __uint_as_float(xv.w << 16), __uint_as_float(xv.w & 0xffff0000u));
                    }
                    float4 y0, y1;
                    y0.x = x0.x + alpha * acc[ai][bj][m][0][0]; y0.y = x0.y + alpha * acc[ai][bj][m][0][1]; y0.z = x0.z + alpha * acc[ai][bj][m][0][2]; y0.w = x0.w + alpha * acc[ai][bj][m][0][3];
                    y1.x = x1.x + alpha * acc[ai][bj][m][1][0]; y1.y = x1.y + alpha * acc[ai][bj][m][1][1]; y1.z = x1.z + alpha * acc[ai][bj][m][1][2]; y1.w = x1.w + alpha * acc[ai][bj][m][1][3];
                    if (XO) { *(float4*)(XO + idx) = y0; *(float4*)(XO + idx + 4) = y1; }
                    else {
                        *(uint4*)(XB + idx) = make_uint4(pack2(y0.x, y0.y), pack2(y0.z, y0.w), pack2(y1.x, y1.y), pack2(y1.z, y1.w));
                        sq += (y0.x * y0.x + y0.y * y0.y) + (y0.z * y0.z + y0.w * y0.w) + (y1.x * y1.x + y1.y * y1.y) + (y1.z * y1.z + y1.w * y1.w);
                    }
                }
                if (!XO) {
                    sq += xshfl(sq, 16); sq += xshfl(sq, 32);
                    if (fq == 0) xs[(ai * 128 + wr * 64 + m * 16 + fr) * 4 + wc] = sq;
                }
            }
        if (!XO) {
            __syncthreads();
            const int t9 = ((wr * 4 + wc) << 6) | (fq << 4) | fr;
            if (t9 < 256) {
                const float v0 = xs[t9 * 4], v1 = xs[t9 * 4 + 1], v2 = xs[t9 * 4 + 2], v3 = xs[t9 * 4 + 3];
                ssq[(size_t)(u.pm * 256 + t9) * SSQW + u.pn] = (v0 + v1) + (v2 + v3);
            }
        }
    }
};
DI void prep_tables(unsigned char* ws, int vb, int vg, HB& hb) {
    float2* rope = (float2*)(ws + WS_ROPE);
    bf16_t* w1a = (bf16_t*)(ws + WS_W1_64);
    bf16_t* w1b = (bf16_t*)(ws + WS_W1_128);
    bf16_t* w2 = (bf16_t*)(ws + WS_W2_64);
    const int gt = vb * 256 + TID256(hb), gs = vg * 256;
    for (int i = gt; i < 128 * 16; i += gs) {
        const int pos = i >> 4, f = i & 15;
        const float freq = exp2f(-(float)f * (13.287712379549449f / 16.0f));
        float s, c; sincosf((float)pos * freq, &s, &c);
        rope[i] = make_float2(c, s);
    }
    for (int i = gt; i < 128 * 128; i += gs) {
        const int m = i >> 7, k = i & 127, mm = m & 63, kk = k & 63;
        float s, c; sincospif((float)((mm * kk) & 63) / 32.0f, &s, &c);
        c *= 0.125f; s *= 0.125f;
        const float v = (m < 64) ? (k < 64 ? c : s) : (k < 64 ? -s : c);
        w1a[i] = f2bf(v);
    }
    for (int i = gt; i < 256 * 256; i += gs) {
        const int m = i >> 8, k = i & 255, mm = m & 127, kk = k & 127;
        float s, c; sincospif((float)((mm * kk) & 127) / 64.0f, &s, &c);
        c *= 0.08838834764831845f; s *= 0.08838834764831845f;
        const float v = (m < 128) ? (k < 128 ? c : s) : (k < 128 ? -s : c);
        w1b[i] = f2bf(v);
    }
    for (int i = gt; i < 64 * 128; i += gs) {
        const int m = i >> 7, k = i & 127, kk = k & 63;
        float s, c; sincospif((float)((m * kk) & 63) / 32.0f, &s, &c);
        w2[i] = f2bf((k < 64 ? c : s) * 0.125f);
    }
}

DI void tok_info(int tok, int& S, int& seq_tok0, int& s) {
    if (tok < MP) { S = 4096; seq_tok0 = tok & ~4095; s = tok & 4095; }
    else { S = 8192; seq_tok0 = MP + ((tok - MP) & ~8191); s = (tok - MP) & 8191; }
}

struct EpiZ0 {
    static constexpr bool PERM = true, AFTER_DRAIN = false;
    bf16_t* Z; const float* ssq;
    DI void operator()(const f32x4 (&acc)[2][2][4][2], const pg8::Unit& u, int wr, int wc, int fr, int fq) const {
        const int row0 = u.pm * 256 + wr * 64 + fr, col0 = 256 + u.pn * 256 + wc * 32 + 8 * fq;
#pragma unroll
        for (int ai = 0; ai < 2; ++ai)
#pragma unroll
            for (int m = 0; m < 4; ++m) {
                const int row = row0 + ai * 128 + m * 16;
                const float r = row_rstd(ssq, row);
#pragma unroll
                for (int bj = 0; bj < 2; ++bj) {
                    const f32x4 v0 = acc[ai][bj][m][0] * r, v1 = acc[ai][bj][m][1] * r;
                    *(uint4*)(Z + (size_t)row * ZW + col0 + bj * 128) = make_uint4(pack2(v0[0], v0[1]), pack2(v0[2], v0[3]), pack2(v1[0], v1[1]), pack2(v1[2], v1[3]));
                }
            }
    }
};

DI void qkprep_phase(bf16_t* __restrict__ z0, bf16_t* __restrict__ vt, const float* __restrict__ qn, const float* __restrict__ kn, const float2* __restrict__ rope, char* smem, int vb, int vg, HB& hb) {
    bf16_t* T = (bf16_t*)smem;
    float* gq = (float*)(smem + 64 * 264 * 2);
    const int tid = launder(TID256(hb));
    if (tid < 64) { gq[tid] = qn[tid]; gq[64 + tid] = kn[tid]; }
    hb_sync(hb);
    for (int u = vb; u < MTOK / 64; u += vg) {
        const int tok0 = u * 64;
        int S, seq0, s0; tok_info(tok0, S, seq0, s0);
        const int row_id = s0 >> 6;
#pragma unroll 1
        for (int it = 0; it < 4; ++it) {
            const int pidx = tid + 256 * it, tk = pidx >> 4, hh = pidx & 15;
            const bool isq = hh < 12;
            bf16_t* ptr = z0 + (size_t)(tok0 + tk) * ZW + (isq ? 256 + hh * 64 : 1536 + (hh - 12) * 64);
            const float* gg = gq + (isq ? 0 : 64);
            float x[64];
#pragma unroll
            for (int c = 0; c < 8; ++c) {
                const uint4 v = ((const uint4*)ptr)[c];
                const unsigned wv[4] = {v.x, v.y, v.z, v.w};
#pragma unroll
                for (int q = 0; q < 4; ++q) { x[c * 8 + 2 * q] = __uint_as_float(wv[q] << 16); x[c * 8 + 2 * q + 1] = __uint_as_float(wv[q] & 0xffff0000u); }
            }
            float ss = 0.f;
#pragma unroll
            for (int d = 0; d < 64; ++d) ss += x[d] * x[d];
            float r = rsqrtf(ss * (1.0f / 64.0f) + EPS);
#pragma unroll
            for (int d = 0; d < 64; ++d) x[d] = x[d] * r * gg[d];
            const float sc = isq ? 0.125f * 1.4426950408889634f : 1.0f;
            const float2* rr = rope + row_id * 16;
            const float2* rc = rope + tk * 16;
            float y[64];
#pragma unroll
            for (int f = 0; f < 16; ++f) {
                const float2 a = rr[f], b = rc[f];
                y[f] = (x[f] * a.x - x[16 + f] * a.y) * sc;
                y[16 + f] = (x[f] * a.y + x[16 + f] * a.x) * sc;
                y[32 + f] = (x[32 + f] * b.x - x[48 + f] * b.y) * sc;
                y[48 + f] = (x[32 + f] * b.y + x[48 + f] * b.x) * sc;
            }
#pragma unroll
            for (int c = 0; c < 8; ++c)
                ((uint4*)ptr)[c] = make_uint4(pack2(y[c * 8], y[c * 8 + 1]), pack2(y[c * 8 + 2], y[c * 8 + 3]), pack2(y[c * 8 + 4], y[c * 8 + 5]), pack2(y[c * 8 + 6], y[c * 8 + 7]));
        }
        hb_sync(hb);
#pragma unroll
        for (int it = 0; it < 8; ++it) {
            const int pidx = tid + 256 * it, tk = pidx >> 5, c8 = (pidx & 31) * 8;
            *(uint4*)(T + tk * 264 + c8) = *(const uint4*)(z0 + (size_t)(tok0 + tk) * ZW + 1792 + c8);
        }
        hb_sync(hb);
        {
            unsigned o[32];
#pragma unroll
            for (int j = 0; j < 32; ++j) o[j] = (unsigned)T[(2 * j) * 264 + tid] | ((unsigned)T[(2 * j + 1) * 264 + tid] << 16);
            uint4* dp = (uint4*)(vt + (size_t)seq0 * 256 + (size_t)tid * S + s0);
#pragma unroll
            for (int j = 0; j < 8; ++j) dp[j] = make_uint4(o[4 * j], o[4 * j + 1], o[4 * j + 2], o[4 * j + 3]);
        }
    }
    hb_sync(hb);
}

template <int NR>
DI void fourier_ld(const bf16_t* __restrict__ z0, uint4 (&rg)[NR / 16], int rowbase, int rowstride, int cb, int tid) {
#pragma unroll
    for (int it = 0; it < NR / 16; ++it) {
        const int pidx = tid + 256 * it, k = pidx >> 3, c8 = (pidx & 7) * 8;
        const int kk = k & (NR - 1);
        rg[it] = *(const uint4*)(z0 + (size_t)(rowbase + kk * rowstride) * ZW + 1024 + (k >= NR ? 256 : 0) + cb * 64 + c8);
    }
}
template <int NR, int TS>
DI void fourier_st(const uint4 (&rg)[NR / 16], bf16_t* T, int tid) {
#pragma unroll
    for (int it = 0; it < NR / 16; ++it) {
        const int pidx = tid + 256 * it, k = pidx >> 3, c8 = (pidx & 7) * 8;
        const unsigned wv[4] = {rg[it].x, rg[it].y, rg[it].z, rg[it].w};
#pragma unroll
        for (int q = 0; q < 4; ++q) { T[(c8 + 2 * q) * TS + k] = (bf16_t)(wv[q] & 0xffffu); T[(c8 + 2 * q + 1) * TS + k] = (bf16_t)(wv[q] >> 16); }
    }
}

template <int N1>
DI void fourier_stage1(bf16_t* __restrict__ z0, int tok_base, int nseq, const bf16_t* __restrict__ W1, char* smem, int vb, int vg, HB& hb) {
    constexpr int TS = 2 * N1 + 8, S = N1 * 64, KST = N1 / 8;
    constexpr int NNB = (N1 == 64) ? 1 : 2;
    bf16_t* T = (bf16_t*)smem;
    const int tid = launder(TID256(hb)), lane = tid & 63, w = tid >> 6, l31 = lane & 31, lh = lane >> 5;
    const int wp = (N1 == 64) ? (w & 1) : w, nb0 = (N1 == 64) ? (w >> 1) : 0;
    const int total = nseq * 64 * 4;
    uint4 rg[N1 / 16];
    if (vb < total) fourier_ld<N1>(z0, rg, tok_base + (vb >> 8) * S + ((vb >> 2) & 63), 64, vb & 3, tid);
    for (int u = vb; u < total; u += vg) {
        const int cb = u & 3, s2 = (u >> 2) & 63, b = u >> 8;
        const int rowbase = tok_base + b * S + s2;
        hb_sync(hb);
        fourier_st<N1, TS>(rg, T, tid);
        hb_sync(hb);
        { const int un = (u + vg < total) ? u + vg : u;
          fourier_ld<N1>(z0, rg, tok_base + (un >> 8) * S + ((un >> 2) & 63), 64, un & 3, tid); }
        f32x16 are[NNB], aim[NNB];
#pragma unroll
        for (int n = 0; n < NNB; ++n)
#pragma unroll
            for (int i = 0; i < 16; ++i) { are[n][i] = 0.f; aim[n][i] = 0.f; }
        const bf16_t* wre = W1 + (size_t)(32 * wp + l31) * (2 * N1) + lh * 8;
        const bf16_t* wim = wre + (size_t)N1 * (2 * N1);
#pragma unroll 4
        for (int ks = 0; ks < KST; ++ks) {
            const bf16x8 ar = *(const bf16x8*)(wre + ks * 16), ai = *(const bf16x8*)(wim + ks * 16);
#pragma unroll
            for (int n = 0; n < NNB; ++n) {
                const bf16x8 bb = *(const bf16x8*)(T + ((nb0 + n) * 32 + l31) * TS + ks * 16 + lh * 8);
                are[n] = MFMA32(ar, bb, are[n]); aim[n] = MFMA32(ai, bb, aim[n]);
            }
        }
#pragma unroll
        for (int i = 0; i < 16; ++i) {
            const int s1p = 32 * wp + acc_row(i, lh);
            float sn, cs; sincospif(-2.0f * (float)(s2 * s1p) / (float)S, &sn, &cs);
            bf16_t* dst = z0 + (size_t)(rowbase + s1p * 64) * ZW + 1024 + cb * 64;
#pragma unroll
            for (int n = 0; n < NNB; ++n) {
                const float re = are[n][i], im = aim[n][i];
                const int c = (nb0 + n) * 32 + l31;
                dst[c] = f2bf(re * cs - im * sn);
                dst[256 + c] = f2bf(re * sn + im * cs);
            }
        }
    }
    hb_sync(hb);
}

DI void fourier_stage2(bf16_t* __restrict__ z0, int tok_base, int nseq, int N1, const bf16_t* __restrict__ W2, char* smem, int vb, int vg, HB& hb) {
    constexpr int TS = 136;
    bf16_t* T = (bf16_t*)smem;
    const int tid = launder(TID256(hb)), lane = tid & 63, w = tid >> 6, l31 = lane & 31, lh = lane >> 5;
    const int mb = w & 1, nb = w >> 1;
    const int S = N1 * 64, total = nseq * N1 * 4;
    uint4 rg[4];
    if (vb < total) { const int r0 = vb >> 2; fourier_ld<64>(z0, rg, tok_base + (r0 / N1) * S + (r0 % N1) * 64, 1, vb & 3, tid); }
    for (int u = vb; u < total; u += vg) {
        const int cb = u & 3, r = u >> 2, s1p = r % N1, b = r / N1;
        const int rowbase = tok_base + b * S + s1p * 64;
        hb_sync(hb);
        fourier_st<64, TS>(rg, T, tid);
        hb_sync(hb);
        { const int un = (u + vg < total) ? u + vg : u; const int rn = un >> 2;
          fourier_ld<64>(z0, rg, tok_base + (rn / N1) * S + (rn % N1) * 64, 1, un & 3, tid); }
        f32x16 acc;
#pragma unroll
        for (int i = 0; i < 16; ++i) acc[i] = 0.f;
        const bf16_t* wr_ = W2 + (size_t)(32 * mb + l31) * 128 + lh * 8;
#pragma unroll
        for (int ks = 0; ks < 8; ++ks) {
            const bf16x8 a = *(const bf16x8*)(wr_ + ks * 16);
            const bf16x8 bb = *(const bf16x8*)(T + (nb * 32 + l31) * TS + ks * 16 + lh * 8);
            acc = MFMA32(a, bb, acc);
        }
#pragma unroll
        for (int i = 0; i < 16; ++i) {
            const int s2p = 32 * mb + acc_row(i, lh);
            z0[(size_t)(tok_base + b * S + s1p + N1 * s2p) * ZW + cb * 64 + nb * 32 + l31] = f2bf(acc[i]);
        }
    }
    hb_sync(hb);
}

#define ATT_SCORES_PV(KSB, VSB)                                                                                             \
    {                                                                                                                       \
        f32x16 s[2][2];                                                                                                     \
        {     \
            const bf16x8 k0 = *(const bf16x8*)((KSB) + l31 * KS_ + lh * 8);                                                 \
            const bf16x8 k1 = *(const bf16x8*)((KSB) + (32 + l31) * KS_ + lh * 8);                                          \
            const bf16x8 q0 = *(const bf16x8*)(Qw + l31 * KS_ + lh * 8);                                                    \
            const bf16x8 q1 = *(const bf16x8*)(Qw + (32 + l31) * KS_ + lh * 8);                                             \
            s[0][0] = MFMA32(k0, q0, negmb); s[0][1] = MFMA32(k0, q1, negmb);                                               \
            s[1][0] = MFMA32(k1, q0, negmb); s[1][1] = MFMA32(k1, q1, negmb);                                               \
        }                                                                                                                   \
        _Pragma("unroll") for (int ks = 1; ks < 4; ++ks) {                                                                  \
            const bf16x8 k0 = *(const bf16x8*)((KSB) + l31 * KS_ + ks * 16 + lh * 8);                                       \
            const bf16x8 k1 = *(const bf16x8*)((KSB) + (32 + l31) * KS_ + ks * 16 + lh * 8);                                \
            const bf16x8 q0 = *(const bf16x8*)(Qw + l31 * KS_ + ks * 16 + lh * 8);                                          \
            const bf16x8 q1 = *(const bf16x8*)(Qw + (32 + l31) * KS_ + ks * 16 + lh * 8);                                   \
            s[0][0] = MFMA32(k0, q0, s[0][0]); s[0][1] = MFMA32(k0, q1, s[0][1]);                                           \
            s[1][0] = MFMA32(k1, q0, s[1][0]); s[1][1] = MFMA32(k1, q1, s[1][1]);                                           \
        }                                                                                                                   \
        bf16x8 pf[2][4];                                                                                                    \
        _Pragma("unroll") for (int qb = 0; qb < 2; ++qb) {                                                                  \
            float ps = 0.f;                                                                                                 \
            _Pragma("unroll") for (int kb = 0; kb < 2; ++kb) {                                                              \
                _Pragma("unroll") for (int i = 0; i < 16; ++i) { const float pv = __builtin_amdgcn_exp2f(s[kb][qb][i]); s[kb][qb][i] = pv; ps += pv; } \
                _Pragma("unroll") for (int sp = 0; sp < 2; ++sp) {                                                          \
                    u32x4 pk;                                                                                               \
                    pk[0] = pack2(s[kb][qb][8 * sp + 0], s[kb][qb][8 * sp + 1]); pk[1] = pack2(s[kb][qb][8 * sp + 2], s[kb][qb][8 * sp + 3]); \
                    pk[2] = pack2(s[kb][qb][8 * sp + 4], s[kb][qb][8 * sp + 5]); pk[3] = pack2(s[kb][qb][8 * sp + 6], s[kb][qb][8 * sp + 7]); \
                    pf[qb][kb * 2 + sp] = __builtin_bit_cast(bf16x8, pk);                                                   \
                }                                                                                                           \
            }                                                                                                               \
            lsum[qb] += ps;                                                                                                 \
        }                                                                                                                   \
        _Pragma("unroll") for (int kst = 0; kst < 4; ++kst) {                                                               \
            _Pragma("unroll") for (int db = 0; db < 2; ++db) {                                                              \
                const bf16_t* vrow = (VSB) + (db * 32 + l31) * KS_ + kst * 16 + lh * 4;                                     \
                const s16x4 lo = *(const s16x4*)(vrow), hi = *(const s16x4*)(vrow + 8);                                     \
                const bf16x8 vf = __builtin_shufflevector(lo, hi, 0, 1, 2, 3, 4, 5, 6, 7);                                  \
                o[db][0] = MFMA32(vf, pf[0][kst], o[db][0]);                                                                \
                o[db][1] = MFMA32(vf, pf[1][kst], o[db][1]);                                                                \
            }                                                                                                               \
        }                                                                                                                   \
    }
DI void attn_phase(bf16_t* __restrict__ z0, const bf16_t* __restrict__ vt, const float* __restrict__ qn, const float* __restrict__ kn, char* lds0, int wv8) {
    constexpr int KS_ = 72;
    bf16_t* Ks = (bf16_t*)lds0;
    bf16_t* Vs = Ks + 2 * 64 * KS_;
    bf16_t* Qw = Vs + 2 * 64 * KS_ + wv8 * 64 * KS_;
    const int tid = launder((wv8 << 6) | lane_id()), lane = tid & 63, w = tid >> 6, l31 = lane & 31, lh = lane >> 5;
    const int lr = tid >> 3, lc = (tid & 7) * 8;
    float mb;
    {
        float gq = fabsf(qn[lane]), gk = fabsf(kn[lane]);
#pragma unroll
        for (int off = 1; off < 64; off <<= 1) { gq = fmaxf(gq, xshfl(gq, off)); gk = fmaxf(gk, xshfl(gk, off)); }
        mb = 8.0f * 1.4426950408889634f * gq * gk;
    }
    f32x16 negmb;
#pragma unroll
    for (int i = 0; i < 16; ++i) negmb[i] = -mb;
    for (int t = blockIdx.x; t < 3072; t += gridDim.x) {
        const int x = t & 7, j = t >> 3;
        int S, seq0, kvh, qblk, g;
        if (j < 192) { const int pair = x * 4 + j / 48, r = j % 48; S = 8192; seq0 = MP + (pair >> 2) * 8192; kvh = pair & 3; qblk = r / 3; g = r % 3; }
        else { const int jj = j - 192, pair = x * 8 + jj / 24, r = jj % 24; S = 4096; seq0 = (pair >> 2) * 4096; kvh = pair & 3; qblk = r / 3; g = r % 3; }
        const int hq = kvh * 3 + g;
        const int qrow0 = seq0 + qblk * 512 + w * 64;
        __syncthreads();
        {
            const bf16_t* qsrc = z0 + (size_t)qrow0 * ZW + 256 + hq * 64;
            const int ln = launder(lane);
            const int r0 = ln >> 3, c8 = (ln & 7) * 8;
            const unsigned go = (unsigned)(r0 * ZW + c8); const int lo = r0 * KS_ + c8;
#pragma unroll
            for (int i = 0; i < 8; ++i)
                *(uint4*)(Qw + lo + i * 8 * KS_) = *(const uint4*)(qsrc + go + (unsigned)(i * 8 * ZW));
        }
        const bf16_t* kp = z0 + (size_t)seq0 * ZW + 1536 + kvh * 64;
        const bf16_t* vp = vt + (size_t)seq0 * 256 + (size_t)(kvh * 64) * S;
        const unsigned offk = (unsigned)(lr * ZW + lc), offv = (unsigned)(lr * S + lc);
        const int lo4 = lr * KS_ + lc;
        const int nkt = S >> 6;
        uint4 rkA = *(const uint4*)(kp + offk), rvA = *(const uint4*)(vp + offv);
        *(uint4*)(Ks + lo4) = rkA; *(uint4*)(Vs + lo4) = rvA;
        __syncthreads();
        f32x16 o[2][2];
#pragma unroll
        for (int a = 0; a < 2; ++a)
#pragma unroll
            for (int b = 0; b < 2; ++b)
#pragma unroll
                for (int i = 0; i < 16; ++i) o[a][b][i] = 0.f;
        float lsum[2] = {0.f, 0.f};
        for (int kt = 0; kt < nkt; ++kt) {
            const int buf = kt & 1;
            if (kt + 1 < nkt) { rkA = *(const uint4*)(kp + (size_t)((kt + 1) * 64) * ZW + offk); rvA = *(const uint4*)(vp + (kt + 1) * 64 + offv); }
            const bf16_t* ksb = Ks + buf * 64 * KS_; const bf16_t* vsb = Vs + buf * 64 * KS_;
            ATT_SCORES_PV(ksb, vsb)
            if (kt + 1 < nkt) { *(uint4*)(Ks + (buf ^ 1) * 64 * KS_ + lo4) = rkA; *(uint4*)(Vs + (buf ^ 1) * 64 * KS_ + lo4) = rvA; }
            __syncthreads();
        }
        const int t3 = launder(tid);
        const int row3 = seq0 + qblk * 512 + (t3 >> 6) * 64 + (t3 & 31), lh3 = (t3 >> 5) & 1;
#pragma unroll
        for (int qb = 0; qb < 2; ++qb) {
            const float l = lsum[qb] + xshfl(lsum[qb], 32);
            const float inv = 1.0f / l;
            bf16_t* dst = z0 + (size_t)(row3 + qb * 32) * ZW + 256 + hq * 64;
#pragma unroll
            for (int db = 0; db < 2; ++db)
#pragma unroll
                for (int g4 = 0; g4 < 4; ++g4) {
                    u32x2 pk;
                    pk[0] = pack2(o[db][qb][4 * g4] * inv, o[db][qb][4 * g4 + 1] * inv);
                    pk[1] = pack2(o[db][qb][4 * g4 + 2] * inv, o[db][qb][4 * g4 + 3] * inv);
                    *(u32x2*)(dst + db * 32 + 8 * g4 + 4 * lh3) = pk;
                }
        }
    }
    __syncthreads();
}

struct EpiZ1 {
    static constexpr bool PERM = true, AFTER_DRAIN = false;
    bf16_t* Z; float* G; const float* bias; const float* ssq;
    DI void operator()(const f32x4 (&acc)[2][2][4][2], const pg8::Unit& u, int wr, int wc, int fr, int fq) const {
        const int row0 = u.pm * 256 + wr * 64 + fr, col0 = u.pn * 256 + wc * 32 + 8 * fq;
#pragma unroll
        for (int ai = 0; ai < 2; ++ai)
#pragma unroll
            for (int m = 0; m < 4; ++m) {
                const int row = row0 + ai * 128 + m * 16;
                const float r = row_rstd(ssq, row);
#pragma unroll
                for (int bj = 0; bj < 2; ++bj) {
                    const int col = col0 + bj * 128;
                    const f32x4 v0 = acc[ai][bj][m][0] * r, v1 = acc[ai][bj][m][1] * r;
                    if (col < 4096) {
                        *(uint4*)(Z + (size_t)row * 4096 + col) = make_uint4(pack2(v0[0], v0[1]), pack2(v0[2], v0[3]), pack2(v1[0], v1[1]), pack2(v1[2], v1[3]));
                    } else if (col < 4112) {
                        const float4 b0 = *(const float4*)(bias + (col - 4096)), b1 = *(const float4*)(bias + (col - 4096) + 4);
                        float* gp = G + (size_t)row * 16 + (col - 4096);
                        *(float4*)gp = make_float4(v0[0] + b0.x, v0[1] + b0.y, v0[2] + b0.z, v0[3] + b0.w);
                        *(float4*)(gp + 4) = make_float4(v1[0] + b1.x, v1[1] + b1.y, v1[2] + b1.z, v1[3] + b1.w);
                    }
                }
            }
    }
};

#define BLO(u) __uint_as_float((u) << 16)
#define BHI(u) __uint_as_float((u) & 0xffff0000u)
DI void conv_load(const bf16_t* __restrict__ z1, int col, int tok0, int s0, int S, int r0, uint4 (&rows)[10]) {
#pragma unroll
    for (int i = 0; i < 10; ++i) {
        const int r = r0 - 1 + i, sq = s0 + r;
        rows[i] = make_uint4(0, 0, 0, 0);
        if (sq >= 0 && sq < S) rows[i] = *(const uint4*)(z1 + (size_t)(tok0 + r) * 4096 + col);
    }
}
DI void conv_apply(const uint4 (&rows)[10], const float* __restrict__ cw, int col, int tok0, int r0, float osc, bf16_t* T, int c8, bf16_t* __restrict__ gdst) {
    float w0[8], w1[8], w2[8];
#pragma unroll
    for (int e = 0; e < 8; ++e) { w0[e] = cw[col + e]; w1[e] = cw[2048 + col + e]; w2[e] = cw[4096 + col + e]; }
#pragma unroll
    for (int i = 0; i < 8; ++i) {
        const uint4 p = rows[i], c = rows[i + 1], n = rows[i + 2];
        const float xp[8] = {BLO(p.x), BHI(p.x), BLO(p.y), BHI(p.y), BLO(p.z), BHI(p.z), BLO(p.w), BHI(p.w)};
        const float xc[8] = {BLO(c.x), BHI(c.x), BLO(c.y), BHI(c.y), BLO(c.z), BHI(c.z), BLO(c.w), BHI(c.w)};
        const float xn[8] = {BLO(n.x), BHI(n.x), BLO(n.y), BHI(n.y), BLO(n.z), BHI(n.z), BLO(n.w), BHI(n.w)};
        float y[8];
#pragma unroll
        for (int e = 0; e < 8; ++e) {
            const float a = xp[e] * w0[e] + xc[e] * w1[e] + xn[e] * w2[e];
            y[e] = a * __builtin_amdgcn_rcpf(1.0f + __builtin_amdgcn_exp2f(-1.4426950408889634f * a)) * osc;
        }
        const uint4 ov = make_uint4(pack2(y[0], y[1]), pack2(y[2], y[3]), pack2(y[4], y[5]), pack2(y[6], y[7]));
        const int r = r0 + i;
        if (gdst) *(uint4*)(gdst + (size_t)(tok0 + r) * 1024 + c8) = ov;
        *(uint4*)(T + r * 264 + c8) = ov;
    }
}
DI void transpose_out(const bf16_t* T, bf16_t* __restrict__ base, HB& hb) {
    const int tid = launder(TID256(hb));
    unsigned o[32];
#pragma unroll
    for (int j = 0; j < 32; ++j) o[j] = (unsigned)T[(2 * j) * 264 + tid] | ((unsigned)T[(2 * j + 1) * 264 + tid] << 16);
#pragma unroll
    for (int j = 0; j < 8; ++j) ((uint4*)base)[j] = make_uint4(o[4 * j], o[4 * j + 1], o[4 * j + 2], o[4 * j + 3]);
}
DI void conv_phase(const bf16_t* __restrict__ z1, bf16_t* __restrict__ qc, bf16_t* __restrict__ kT, bf16_t* __restrict__ vT, bf16_t* __restrict__ sfr,
                   const float* __restrict__ gates, float4* __restrict__ gsc, const float* __restrict__ cw, int S, int gtok, char* smem, int vb, int vg, HB& hb) {
    bf16_t* TQ = (bf16_t*)smem;
    bf16_t* TK = TQ + 64 * 264;
    const int tid = launder(TID256(hb)), rg = tid >> 5, c8 = (tid & 31) * 8;
    const int lane = tid & 63, w = tid >> 6, l31 = lane & 31, lh = lane >> 5, jb = w & 1, eb = w >> 1;
    const int total = (gtok / 64) * 4;
    for (int u = vb; u < total; u += vg) {
        const int hd = u & 3, blk = u >> 2;
        const int tok0 = blk * 64, s0 = tok0 % S, seq = tok0 / S;
        const size_t tbase = ((size_t)(seq * 4 + hd) * 256 + tid) * S + s0;
        hb_sync(hb);
        uint4 vrow[8], qrow[10], krow[10];
#pragma unroll
        for (int i = 0; i < 8; ++i) vrow[i] = *(const uint4*)(z1 + (size_t)(tok0 + rg * 8 + i) * 4096 + 2048 + hd * 256 + c8);
        conv_load(z1, hd * 256 + c8, tok0, s0, S, rg * 8, qrow);
        conv_load(z1, 1024 + hd * 256 + c8, tok0, s0, S, rg * 8, krow);
#pragma unroll
        for (int i = 0; i < 8; ++i) *(uint4*)(TQ + (rg * 8 + i) * 264 + c8) = vrow[i];
        hb_sync(hb);
        transpose_out(TQ, vT + tbase, hb);
        hb_sync(hb);
        conv_apply(qrow, cw, hd * 256 + c8, tok0, rg * 8, 1.0f, TQ, c8, qc + hd * 256);
        conv_apply(krow, cw, 1024 + hd * 256 + c8, tok0, rg * 8, 0.0625f, TK, c8, nullptr);
        hb_sync(hb);
        transpose_out(TK, kT + tbase, hb);
        f32x16 acc;
#pragma unroll
        for (int i = 0; i < 16; ++i) acc[i] = 0.f;
#pragma unroll 4
        for (int ks = 0; ks < 16; ++ks) {
            const bf16x8 kf = *(const bf16x8*)(TK + (eb * 32 + l31) * 264 + ks * 16 + lh * 8);
            const bf16x8 qf = *(const bf16x8*)(TQ + (jb * 32 + l31) * 264 + ks * 16 + lh * 8);
            acc = MFMA32(kf, qf, acc);
        }
        if (w < 2) {
            const int dir = w, r = dir ? 63 - lane : lane;
            const float ig = gates[(size_t)(tok0 + r) * 16 + dir * 8 + hd], fg = gates[(size_t)(tok0 + r) * 16 + dir * 8 + 4 + hd];
            float bcs = fminf(fg, 0.f) - __logf(1.0f + __expf(-fabsf(fg)));
#pragma unroll
            for (int off = 1; off < 64; off <<= 1) { const float tt = bperm(bcs, lane - off); if (lane >= off) bcs += tt; }
            const float av = ig - bcs;
            float cm = av;
#pragma unroll
            for (int off = 1; off < 64; off <<= 1) { const float tt = bperm(cm, lane - off); if (lane >= off) cm = fmaxf(cm, tt); }
            gsc[((size_t)(blk * 4 + hd) * 2 + dir) * 64 + lane] = make_float4(bcs, av, cm, 0.f);
        }
        uint4* sd = (uint4*)(sfr + ((size_t)(blk * 4 + hd) * 256 + tid) * 16);
        sd[0] = make_uint4(pack2(acc[0], acc[1]), pack2(acc[2], acc[3]), pack2(acc[4], acc[5]), pack2(acc[6], acc[7]));
        sd[1] = make_uint4(pack2(acc[8], acc[9]), pack2(acc[10], acc[11]), pack2(acc[12], acc[13]), pack2(acc[14], acc[15]));
    }
    hb_sync(hb);
}

DI uint4 scale8(uint4 v, const float* wsp) {
    return make_uint4(pack2(BLO(v.x) * wsp[0], BHI(v.x) * wsp[1]), pack2(BLO(v.y) * wsp[2], BHI(v.y) * wsp[3]),
                      pack2(BLO(v.z) * wsp[4], BHI(v.z) * wsp[5]), pack2(BLO(v.w) * wsp[6], BHI(v.w) * wsp[7]));
}
DI void mlstm_phase(const bf16_t* __restrict__ qc, const bf16_t* __restrict__ kT, const bf16_t* __restrict__ vT, const bf16_t* __restrict__ sfr,
                    const float4* __restrict__ gsc, bf16_t* __restrict__ hout  , int S, int nseq, char* lds0, int wv8) {
    constexpr int LS = 72, TILE = 64 * LS;
    const int sub = wv8 >> 2;
    bf16_t* QS = (bf16_t*)lds0 + sub * 3 * TILE;
    bf16_t* KT = QS + TILE;
    bf16_t* CL = KT + TILE;
    bf16_t* VT = (bf16_t*)lds0 + 6 * TILE;
    bf16_t* PL = VT + 2 * TILE;
    float* NV = (float*)(PL + TILE);
    bf16_t* NVB = (bf16_t*)(NV + 512);
    float* TA = NV + 512 + 256;
    float* TM = TA + 64;
    float* TWI = TM + 64;
    float* TEL = TWI + 64;
    float* TNQ = TEL + 64;
    float* TRS = TNQ + 128;
    float* IX = TRS + 128;
    const int lane = launder(lane_id()), w = wv8 & 3, l31 = lane & 31, lh = lane >> 5;
    const int t8 = (w << 6) | lane;
    const int jb = w & 1, eb = w >> 1, db = w & 1;
    const int lr = t8 >> 3, lc = (t8 & 7) * 8;
    const int nC = S >> 6;
    const int total = nseq * 32;
    const unsigned offq0 = (unsigned)(lr * 1024 + lc), offq1 = (unsigned)((lr + 32) * 1024 + lc);
    const unsigned offt0 = (unsigned)(lr * S + lc), offt1 = (unsigned)((lr + 32) * S + lc);
    for (int u = blockIdx.x; u < total; u += gridDim.x) {
        const int es = u & 3, dir = (u >> 2) & 1, hd = (u >> 3) & 3, seq = u >> 5;
        const size_t tokseq = (size_t)seq * S;
        const bf16_t* qg = qc + tokseq * 1024 + hd * 256;
        const bf16_t* sg = sfr + ((size_t)(seq * nC) * 4 + hd) * 4096;
        const bf16_t* kTg = kT + (size_t)(seq * 4 + hd) * 256 * S;
        const bf16_t* vTg = vT + ((size_t)(seq * 4 + hd) * 256 + es * 64) * S;
        const float4* gg = gsc + ((size_t)(seq * nC) * 4 + hd) * 128 + dir * 64;
        f32x16 ct0, ct1;
#pragma unroll
        for (int i = 0; i < 16; ++i) { ct0[i] = 0.f; ct1[i] = 0.f; }
        float mst = 0.f;
        __syncthreads();
        { const int t2 = launder(t8) + sub * 256; NV[t2] = 0.f; NVB[t2] = 0; }
        uint4 rqX0, rqX1, rtX0, rtX1, rqY0, rqY1, rtY0, rtY1, rv0, rv1, rs0, rs1;
        float4 gs_n;
        {
            const int s0 = (dir ? nC - 1 : 0) * 64;
            const bf16_t* qb_ = qg + (size_t)s0 * 1024 + sub * 64;
            const bf16_t* tb_ = kTg + (size_t)(sub * 64) * S + s0;
            rqX0 = *(const uint4*)(qb_ + offq0); rqX1 = *(const uint4*)(qb_ + offq1);
            rtX0 = *(const uint4*)(tb_ + offt0); rtX1 = *(const uint4*)(tb_ + offt1);
            rqY0 = *(const uint4*)(qb_ + 128 + offq0); rqY1 = *(const uint4*)(qb_ + 128 + offq1);
            rtY0 = *(const uint4*)(tb_ + (size_t)128 * S + offt0); rtY1 = *(const uint4*)(tb_ + (size_t)128 * S + offt1);
            gs_n = gg[(size_t)(s0 >> 6) * 512 + lane];
            if (sub == 0) {
                const bf16_t* vb_ = vTg + s0; rv0 = *(const uint4*)(vb_ + offt0); rv1 = *(const uint4*)(vb_ + offt1);
                *(uint4*)(VT + lr * LS + lc) = rv0; *(uint4*)(VT + (lr + 32) * LS + lc) = rv1;
            }
        }
        for (int c = 0; c < nC; ++c) {
            const int par = c & 1;
            const int s0 = (dir ? nC - 1 - c : c) * 64;
            const int s0n = (dir ? nC - 2 - c : c + 1) * 64;
            const bool has_next = c + 1 < nC;
            const int ll = launder(lane);
            const float bcs = gs_n.x, av = gs_n.y, cm = gs_n.z;
            const float Mj = fmaxf(mst, cm);
            const float wi = __expf(mst - Mj);
            const float el = __expf(-(bcs + Mj));
            const float M63 = rdlane(Mj, 63);
            const float wsv = __expf(av - M63);
            const float decay = rdlane(wi, 63);
            const float mnew = rdlane(bcs, 63) + M63;
            if (has_next) gs_n = gg[(size_t)(s0n >> 6) * 512 + ll];
            f32x16 iacc;
#pragma unroll
            for (int i = 0; i < 16; ++i) iacc[i] = 0.f;
            float nqp = 0.f;
            const float* nvo = NV + par * 256;
            float* nvn = NV + (par ^ 1) * 256;
            const bf16_t* nbo = NVB + par * 256;
            bf16_t* nbn = NVB + (par ^ 1) * 256;
            const bf16_t* VTU = VT + par * TILE;
            float wsp[8];
            { const int lcl = launder(lc);
#pragma unroll
              for (int e = 0; e < 8; ++e) { const int r = lcl + e; wsp[e] = bperm(wsv, dir ? 63 - r : r); } }
#define MLSTM_IT(it, CT, rq0, rq1, rt0, rt1)                                                                               \
            {                                                                                                              \
                const int dc = 2 * it + sub;                                                                               \
                __syncthreads();                                                                             \
                {                                                                                                          \
                    *(uint4*)(QS + lr * LS + lc) = rq0; *(uint4*)(QS + (lr + 32) * LS + lc) = rq1;                        \
                    *(uint4*)(KT + lr * LS + lc) = scale8(rt0, wsp); *(uint4*)(KT + (lr + 32) * LS + lc) = scale8(rt1, wsp); \
                }                                                                                                          \
                _Pragma("unroll") for (int g4 = 0; g4 < 4; ++g4) {                                                         \
                    u32x2 pk;                                                                                              \
                    pk[0] = pack2(CT[4 * g4], CT[4 * g4 + 1]); pk[1] = pack2(CT[4 * g4 + 2], CT[4 * g4 + 3]);              \
                    *(u32x2*)(CL + (eb * 32 + l31) * LS + db * 32 + 8 * g4 + 4 * lh) = pk;                                 \
                }                                                                                                          \
                if (it == 0 && wv8 == 0) { const int r = dir ? 63 - ll : ll; TA[r] = av; TM[r] = Mj; TWI[r] = wi; TEL[r] = el; } \
                if (it == 1 && has_next && sub == 0) { bf16_t* vn = VT + (par ^ 1) * TILE; *(uint4*)(vn + lr * LS + lc) = rv0; *(uint4*)(vn + (lr + 32) * LS + lc) = rv1; } \
                __syncthreads();                                                                             \
                if (has_next) {     \
                    const bf16_t* qb_ = qg + (size_t)s0n * 1024 + (2 * it + sub) * 64;                                     \
                    const bf16_t* tb_ = kTg + (size_t)((2 * it + sub) * 64) * S + s0n;                                     \
                    rq0 = *(const uint4*)(qb_ + offq0); rq1 = *(const uint4*)(qb_ + offq1);                                \
                    rt0 = *(const uint4*)(tb_ + offt0); rt1 = *(const uint4*)(tb_ + offt1);                                \
                }                                                                                                          \
                if (it == 0) {                                                                                             \
                    if (has_next && sub == 0) { const bf16_t* vb_ = vTg + s0n; rv0 = *(const uint4*)(vb_ + offt0); rv1 = *(const uint4*)(vb_ + offt1); } \
                } else {                                                                                                   \
                    if (sub == 0) { const uint4* sp_ = (const uint4*)(sg + (size_t)(s0 >> 6) * 16384 + (unsigned)(launder(t8) * 16)); rs0 = sp_[0]; rs1 = sp_[1]; } \
                }                                                                                                          \
                _Pragma("unroll") for (int ks = 0; ks < 4; ++ks) {                                                         \
                    const bf16x8 qf = *(const bf16x8*)(QS + (jb * 32 + l31) * LS + ks * 16 + lh * 8);                      \
                    const bf16x8 cf = *(const bf16x8*)(CL + (eb * 32 + l31) * LS + ks * 16 + lh * 8);                      \
                    iacc = MFMA32(cf, qf, iacc);                                                                           \
                }                                                                                                          \
                __builtin_amdgcn_sched_barrier(0);                                                                         \
                {                                                                                                          \
                    const int jj = t8 >> 2, part = t8 & 3;                                                                 \
                    {                                                                                                      \
                        const uint4 q0 = *(const uint4*)(QS + jj * LS + part * 16), q1 = *(const uint4*)(QS + jj * LS + part * 16 + 8); \
                        const uint4 n0 = *(const uint4*)(nbo + dc * 64 + part * 16), n1 = *(const uint4*)(nbo + dc * 64 + part * 16 + 8); \
                        nqp = DOT2(q0.x, n0.x, nqp); nqp = DOT2(q0.y, n0.y, nqp); nqp = DOT2(q0.z, n0.z, nqp); nqp = DOT2(q0.w, n0.w, nqp); \
                        nqp = DOT2(q1.x, n1.x, nqp); nqp = DOT2(q1.y, n1.y, nqp); nqp = DOT2(q1.z, n1.z, nqp); nqp = DOT2(q1.w, n1.w, nqp); \
                    }                                                                                                      \
                    {                                                                                                      \
                        const uint4 q0 = *(const uint4*)(KT + jj * LS + part * 16), q1 = *(const uint4*)(KT + jj * LS + part * 16 + 8); \
                        const unsigned one2 = 0x3f803f80u;                                                                 \
                        float acc_n = DOT2(q0.x, one2, 0.f); acc_n = DOT2(q0.y, one2, acc_n); acc_n = DOT2(q0.z, one2, acc_n); acc_n = DOT2(q0.w, one2, acc_n); \
                        acc_n = DOT2(q1.x, one2, acc_n); acc_n = DOT2(q1.y, one2, acc_n); acc_n = DOT2(q1.z, one2, acc_n); acc_n = DOT2(q1.w, one2, acc_n); \
                        acc_n += dpp_xor1(acc_n); acc_n += dpp_xor2(acc_n);                                                \
                        if (part == 0) { const float nn = decay * nvo[dc * 64 + jj] + acc_n; nvn[dc * 64 + jj] = nn; nbn[dc * 64 + jj] = f2bf(nn); } \
                    }                                                                                                      \
                }                                                                                                          \
                __builtin_amdgcn_sched_barrier(0);                                                                         \
                _Pragma("unroll") for (int i = 0; i < 16; ++i) CT[i] *= decay;                                             \
                _Pragma("unroll") for (int ks = 0; ks < 4; ++ks) {                                                         \
                    const bf16x8 af = *(const bf16x8*)(KT + (db * 32 + l31) * LS + ks * 16 + lh * 8);                      \
                    const bf16x8 bf = *(const bf16x8*)(VTU + (eb * 32 + l31) * LS + ks * 16 + lh * 8);                     \
                    CT = MFMA32(af, bf, CT);                                                                               \
                }                                                                                                          \
            }
            MLSTM_IT(0, ct0, rqX0, rqX1, rtX0, rtX1) MLSTM_IT(1, ct1, rqY0, rqY1, rtY0, rtY1)
#undef MLSTM_IT
            nqp += dpp_xor1(nqp); nqp += dpp_xor2(nqp);
            if ((t8 & 3) == 0) TNQ[sub * 64 + (t8 >> 2)] = nqp;
            const int jr = jb * 32 + l31;
            if (sub == 1) {
#pragma unroll
                for (int i = 0; i < 16; ++i) IX[(w * 16 + i) * 64 + lane] = iacc[i];
            } else {
                const float Mq = TM[jr];
                const int jrl = launder(jr);
                float rowsum = 0.f;
                const unsigned sw[8] = {rs0.x, rs0.y, rs0.z, rs0.w, rs1.x, rs1.y, rs1.z, rs1.w};
#pragma unroll
                for (int g4 = 0; g4 < 4; ++g4) {
                    const int sr0 = eb * 32 + 8 * g4 + 4 * lh;
                    const float4 ta = *(const float4*)(TA + sr0);
                    const float tav[4] = {ta.x, ta.y, ta.z, ta.w};
                    float pv[4];
#pragma unroll
                    for (int q = 0; q < 4; ++q) {
                        const int sr = sr0 + q;
                        const bool ok = dir ? (sr >= jrl) : (sr <= jrl);
                        const unsigned swv = sw[2 * g4 + (q >> 1)];
                        const float sv = (q & 1) ? BHI(swv) : BLO(swv);
                        pv[q] = ok ? sv * __expf(tav[q] - Mq) : 0.f;
                        rowsum += pv[q];
                    }
                    u32x2 pk; pk[0] = pack2(pv[0], pv[1]); pk[1] = pack2(pv[2], pv[3]);
                    *(u32x2*)(PL + jr * LS + sr0) = pk;
                }
                rowsum += bperm(rowsum, launder(lane) ^ 32);
                if (lh == 0) TRS[eb * 64 + jr] = rowsum;
            }
            __syncthreads();
            if (sub == 0) {
                const float wiq = TWI[jr], elq = TEL[jr], nq = TNQ[jr] + TNQ[64 + jr];
                const float rowsum = TRS[jr] + TRS[64 + jr];
#pragma unroll
                for (int i = 0; i < 16; ++i) iacc[i] = (iacc[i] + IX[(w * 16 + i) * 64 + lane]) * wiq;
#pragma unroll
                for (int kst = 0; kst < 4; ++kst) {
                    const bf16x8 vf = *(const bf16x8*)(VTU + (eb * 32 + l31) * LS + kst * 16 + lh * 8);
                    const bf16x8 pf = *(const bf16x8*)(PL + jr * LS + kst * 16 + lh * 8);
                    iacc = MFMA32(vf, pf, iacc);
                }
                const float den = wiq * nq + rowsum;
                const float inv = 1.0f / fmaxf(fabsf(den), elq);
                bf16_t* dst = hout + (tokseq + s0) * 4096 + dir * 1024 + hd * 256 + es * 64 + (unsigned)(jr * 4096 + eb * 32);
#pragma unroll
                for (int g4 = 0; g4 < 4; ++g4) {
                    u32x2 pk;
                    pk[0] = pack2(iacc[4 * g4] * inv, iacc[4 * g4 + 1] * inv); pk[1] = pack2(iacc[4 * g4 + 2] * inv, iacc[4 * g4 + 3] * inv);
                    *(u32x2*)(dst + 8 * g4 + 4 * lh) = pk;
                }
            }
            mst = mnew;
        }
    }
    __syncthreads();
}

DI void gatecomb_phase(bf16_t* __restrict__ z1, const float* __restrict__ hn, int gtok, int vb, int vg, HB& hb) {
    const int tid = launder(TID256(hb)); const int lane = tid & 63, w = tid >> 6;
    for (int tok = vb * 4 + w; tok < gtok; tok += vg * 4) {
        bf16_t* base = z1 + (size_t)tok * 4096 + lane * 4;
        uint2 a[4], b[4], o[4];
#pragma unroll
        for (int hd = 0; hd < 4; ++hd) { a[hd] = *(const uint2*)(base + hd * 256); b[hd] = *(const uint2*)(base + 1024 + hd * 256); o[hd] = *(const uint2*)(base + 3072 + hd * 256); }
        float h[4][4], ss[4];
#pragma unroll
        for (int hd = 0; hd < 4; ++hd) {
            h[hd][0] = BLO(a[hd].x) + BLO(b[hd].x); h[hd][1] = BHI(a[hd].x) + BHI(b[hd].x);
            h[hd][2] = BLO(a[hd].y) + BLO(b[hd].y); h[hd][3] = BHI(a[hd].y) + BHI(b[hd].y);
            ss[hd] = h[hd][0] * h[hd][0] + h[hd][1] * h[hd][1] + h[hd][2] * h[hd][2] + h[hd][3] * h[hd][3];
        }
#pragma unroll
        for (int off = 1; off < 64; off <<= 1) {
#pragma unroll
            for (int hd = 0; hd < 4; ++hd) ss[hd] += xshfl(ss[hd], off);
        }
#pragma unroll
        for (int hd = 0; hd < 4; ++hd) {
            const float r = rsqrtf(ss[hd] * (1.0f / 256.0f) + EPS);
            const float4 gv = *(const float4*)(hn + hd * 256 + lane * 4);
            const float gn[4] = {gv.x, gv.y, gv.z, gv.w};
            const float ov[4] = {BLO(o[hd].x), BHI(o[hd].x), BLO(o[hd].y), BHI(o[hd].y)};
            float y[4];
#pragma unroll
            for (int e = 0; e < 4; ++e) y[e] = h[hd][e] * r * gn[e] * __builtin_amdgcn_rcpf(1.0f + __builtin_amdgcn_exp2f(-1.4426950408889634f * ov[e]));
            *(uint2*)(base + 3072 + hd * 256) = make_uint2(pack2(y[0], y[1]), pack2(y[2], y[3]));
        }
    }
}

DI void gsync(unsigned* ctr, unsigned& tgt, int wv8) {
    asm volatile("s_waitcnt vmcnt(0) lgkmcnt(0)" ::: "memory");
    __syncthreads();
    tgt += gridDim.x;
    if (wv8 == 0 && lane_id() == 0) {
        __builtin_amdgcn_fence(__ATOMIC_RELEASE, "agent");
        __hip_atomic_fetch_add(ctr, 1u, __ATOMIC_RELAXED, __HIP_MEMORY_SCOPE_AGENT);
        while (__hip_atomic_load(ctr, __ATOMIC_RELAXED, __HIP_MEMORY_SCOPE_AGENT) < tgt) __builtin_amdgcn_s_sleep(2);
        __builtin_amdgcn_fence(__ATOMIC_ACQUIRE, "agent");
    }
    __syncthreads();
}
template <class Epi>
DI void run_gemm(LAS unsigned char* lds, int wv8, const bf16_t* A, int lda, const bf16_t* Bt, int M, int N, int K, const Epi& e) {
    pg8::Gemm g; g.A = A; g.Bt = Bt; g.M = M; g.N = N; g.K = K; g.lda = lda;
    pg8::StaticOrder so; so.init(M, N, (int)gridDim.x, (int)blockIdx.x);
    pg8::gemm_phase<Epi, pg8::StaticOrder, true, true>(lds, g, so, e, wv8);
}

__global__ void __launch_bounds__(512, 2) mega(Params p) {
    cg::grid_group grid = cg::this_grid();
    extern __shared__ __attribute__((aligned(16))) unsigned char lds_[];
    LAS unsigned char* lds = (LAS unsigned char*)lds_;
    const int wv8 = __builtin_amdgcn_readfirstlane((int)(threadIdx.x >> 6));
    const int half = wv8 >> 2;
    char* smem = (char*)lds_ + half * SMEM_BYTES;
    HB hb; hb.cnt = (LAS unsigned*)(lds + 2 * SMEM_BYTES + half * 128); hb.ep = 0; hb.wv = wv8;
    if ((wv8 & 3) == 0 && lane_id() == 0) *hb.cnt = 0;
    __syncthreads();
    const int vb = (int)blockIdx.x * 2 + half, vg = (int)gridDim.x * 2;
    unsigned char* ws = p.ws;
    bf16_t* xb = (bf16_t*)(ws + WS_XB);
    float* ssq = (float*)(ws + WS_SSQ);
    for (int l = 0; l < 2; ++l) {
        prep_transpose<1>(p.ffn1_w_in + (size_t)l * D * 2 * DFF, p.ffn1_norm + l * D, (bf16_t*)(ws + WS_FFN_WIN + (l * 2 + 0) * SZ_WIN), D, 2 * DFF, 88, smem, vb, vg, hb);
        prep_transpose<1>(p.ffn2_w_in + (size_t)l * D * 2 * DFF, p.ffn2_norm + l * D, (bf16_t*)(ws + WS_FFN_WIN + (l * 2 + 1) * SZ_WIN), D, 2 * DFF, 88, smem, vb, vg, hb);
        prep_transpose<0>(p.ffn1_w_out + (size_t)l * DFF * D, nullptr, (bf16_t*)(ws + WS_FFN_WOUT + (l * 2 + 0) * SZ_WOUT), DFF, D, 16, smem, vb, vg, hb);
        prep_transpose<0>(p.ffn2_w_out + (size_t)l * DFF * D, nullptr, (bf16_t*)(ws + WS_FFN_WOUT + (l * 2 + 1) * SZ_WOUT), DFF, D, 16, smem, vb, vg, hb);
    }
    prep_transpose<2>(p.ab_w_in, p.mix_norm, (bf16_t*)(ws + WS_AB_IN), D, 1536, 28, smem, vb, vg, hb);
    prep_fourier_w(p.ab_w_in, p.mix_norm, (bf16_t*)(ws + WS_AB_IN), smem, vb, vg, hb);
    prep_transpose<0>(p.ab_w_out, nullptr, (bf16_t*)(ws + WS_AB_OUT), D, D, 16, smem, vb, vg, hb);
    prep_transpose<0>(p.c_w_in, p.mix_norm + D, (bf16_t*)(ws + WS_C_IN), D, 4112, 68, smem, vb, vg, hb);
    prep_transpose<0>(p.c_w_out, nullptr, (bf16_t*)(ws + WS_C_OUT), D, D, 16, smem, vb, vg, hb);
    prep_tables(ws, vb, vg, hb);
    {
        const int lane = lane_id(), wv = wv8;
        for (int row = (int)blockIdx.x * 8 + wv; row < MTOK; row += (int)gridDim.x * 8) {
            const float* src = (row < MP ? p.x_in[0] + (size_t)row * D : p.x_in[1] + (size_t)(row - MP) * D);
            bf16_t* dst = xb + (size_t)row * D;
            float sq = 0.f;
#pragma unroll
            for (int i = 0; i < 4; ++i) {
                const float4 v = *(const float4*)(src + i * 256 + lane * 4);
                *(uint2*)(dst + i * 256 + lane * 4) = make_uint2(pack2(v.x, v.y), pack2(v.z, v.w));
                sq += (v.x * v.x + v.y * v.y) + (v.z * v.z + v.w * v.w);
            }
#pragma unroll
            for (int off = 1; off < 64; off <<= 1) sq += xshfl(sq, off);
            if (lane < 4) ssq[(size_t)row * SSQW + lane] = (lane == 0) ? sq : 0.f;
        }
    }
    grid.sync();
    unsigned* gbar = (unsigned*)(ws + WS_BAR); unsigned gtgt = 0;
    bf16_t* hid = (bf16_t*)(ws + WS_BIG);
    for (int l = 0; l < 2; ++l) {
        for (int which = 0; which < 2; ++which) {
            const bf16_t* win = (const bf16_t*)(ws + WS_FFN_WIN + (l * 2 + which) * SZ_WIN);
            const bf16_t* wout = (const bf16_t*)(ws + WS_FFN_WOUT + (l * 2 + which) * SZ_WOUT);
            const bool last_ffn = (l == 1 && which == 1);
            if (!last_ffn) {
                bf16_t* hid1 = (bf16_t*)p.out;
                EpiSwiglu e1; e1.H = hid; e1.H1 = hid1; e1.ssq = ssq;
                run_gemm(lds, hb.wv, xb, D, win, MTOK, 2 * DFF, D, e1);
                gsync(gbar, gtgt, wv8);
                for (int h = 0; h < 2; ++h) {
                    const size_t toff = (size_t)h * MP * D;
                    EpiResid e2; e2.xs = (LAS float*)(lds + 131072); e2.XR = (l == 0 && which == 0) ? p.x_in[h] : nullptr;
                    e2.XO = nullptr; e2.XB = xb + toff; e2.ssq = ssq + (size_t)h * MP * SSQW; e2.alpha = 0.5f;
                    run_gemm(lds, hb.wv, h == 0 ? hid : hid1, DFF, wout, MP, D, DFF, e2);
                }
                gsync(gbar, gtgt, wv8);
            } else {
                for (int h = 0; h < 2; ++h) {
                    const size_t toff = (size_t)h * MP * D;
                    EpiSwiglu e1; e1.H = hid; e1.H1 = hid; e1.ssq = ssq + (size_t)h * MP * SSQW;
                    run_gemm(lds, hb.wv, xb + toff, D, win, MP, 2 * DFF, D, e1);
                    gsync(gbar, gtgt, wv8);
                    EpiResid e2; e2.xs = (LAS float*)(lds + 131072); e2.XR = nullptr;
                    e2.XO = p.out + toff; e2.XB = xb + toff; e2.ssq = ssq + (size_t)h * MP * SSQW; e2.alpha = 0.5f;
                    run_gemm(lds, hb.wv, hid, DFF, wout, MP, D, DFF, e2);
                    gsync(gbar, gtgt, wv8);
                }
            }
            if (which == 1) continue;
            if (l == 0) {
                bf16_t* z0 = (bf16_t*)(ws + WS_BIG);
                bf16_t* vt = (bf16_t*)(ws + WS_BIG + 512 * MiB);
                EpiZ0 ez; ez.Z = z0; ez.ssq = ssq;
                run_gemm(lds, hb.wv, xb, D, (const bf16_t*)(ws + WS_AB_IN), MTOK, ABN, D, ez);
                gsync(gbar, gtgt, wv8);
                qkprep_phase(z0, vt, p.ab_q_norm, p.ab_k_norm, (const float2*)(ws + WS_ROPE), smem, vb, vg, hb);
                fourier_stage1<64>(z0, 0, 16, (const bf16_t*)(ws + WS_W1_64), smem, vb, vg, hb);
                fourier_stage1<128>(z0, MP, 8, (const bf16_t*)(ws + WS_W1_128), smem, vb, vg, hb);
                gsync(gbar, gtgt, wv8);
                attn_phase(z0, vt, p.ab_q_norm, p.ab_k_norm, (char*)lds_, wv8);
                fourier_stage2(z0, 0, 16, 64, (const bf16_t*)(ws + WS_W2_64), smem, vb, vg, hb);
                fourier_stage2(z0, MP, 8, 128, (const bf16_t*)(ws + WS_W2_64), smem, vb, vg, hb);
                gsync(gbar, gtgt, wv8);
                EpiResid eo; eo.xs = (LAS float*)(lds + 131072); eo.XR = nullptr; eo.XO = nullptr; eo.XB = xb; eo.ssq = ssq; eo.alpha = 1.0f;
                run_gemm(lds, hb.wv, z0, ZW, (const bf16_t*)(ws + WS_AB_OUT), MTOK, D, D, eo);
                gsync(gbar, gtgt, wv8);
            } else {
                bf16_t* z1 = (bf16_t*)p.out;
                bf16_t* qc = (bf16_t*)(ws + WS_BIG);
                bf16_t* kTb = (bf16_t*)(ws + WS_BIG + 128 * MiB);
                bf16_t* vTb = (bf16_t*)(ws + WS_BIG + 256 * MiB);
                bf16_t* sfr = (bf16_t*)(ws + WS_BIG + 384 * MiB);
                float4* gsc = (float4*)(ws + WS_BIG + 416 * MiB);
                float* gates = (float*)(ws + WS_BIG + 424 * MiB);
                for (int g = 0; g < 2; ++g) {
                    const int S = g == 0 ? 4096 : 8192, gtok = MP, nseq = gtok / S;
                    const size_t tok0 = (size_t)g * MP;
                    const size_t toff = tok0 * D;
                    EpiZ1 ez; ez.Z = z1; ez.G = gates; ez.bias = p.c_gate_bias; ez.ssq = ssq + tok0 * SSQW;
                    run_gemm(lds, hb.wv, xb + toff, D, (const bf16_t*)(ws + WS_C_IN), gtok, CN, D, ez);
                    gsync(gbar, gtgt, wv8);
                    conv_phase(z1, qc, kTb, vTb, sfr, gates, gsc, p.c_conv, S, gtok, smem, vb, vg, hb);
                    gsync(gbar, gtgt, wv8);
                    mlstm_phase(qc, kTb, vTb, sfr, gsc, z1, S, nseq, (char*)lds_, wv8);
                    gsync(gbar, gtgt, wv8);
                    gatecomb_phase(z1, p.c_head_norm, gtok, vb, vg, hb);
                    gsync(gbar, gtgt, wv8);
                    EpiResid eo; eo.xs = (LAS float*)(lds + 131072); eo.XR = nullptr; eo.XO = nullptr; eo.XB = xb + toff; eo.ssq = ssq + tok0 * SSQW; eo.alpha = 1.0f;
                    run_gemm(lds, hb.wv, z1 + 3072, 4096, (const bf16_t*)(ws + WS_C_OUT), gtok, D, D, eo);
                    gsync(gbar, gtgt, wv8);
                }
            }
        }
    }
}

extern "C" void kernel_launch(void* const* d_in, const int* in_sizes, int n_in, void* d_out, int out_size, void* d_ws, size_t ws_size, hipStream_t stream) {
    static int grid_blocks = 0;
    if (!grid_blocks) {
        int dev = 0, cus = 0, per_cu = 0;
        (void)hipGetDevice(&dev);
        (void)hipDeviceGetAttribute(&cus, hipDeviceAttributeMultiprocessorCount, dev);
        if (hipFuncSetAttribute((const void*)mega, hipFuncAttributeMaxDynamicSharedMemorySize, LDS_BYTES) != hipSuccess) fprintf(stderr, "kernel_launch: hipFuncSetAttribute(%d B LDS) failed\n", LDS_BYTES);
        (void)hipOccupancyMaxActiveBlocksPerMultiprocessor(&per_cu, (const void*)mega, 512, LDS_BYTES);
        if (per_cu < 1) fprintf(stderr, "kernel_launch: occupancy query says %d blocks per CU\n", per_cu);
        (void)hipGetLastError();
        grid_blocks = cus;
        if (ws_size < (size_t)1024 * MiB) fprintf(stderr, "kernel_launch: ws_size %zu smaller than expected 1 GiB\n", ws_size);
    }
    Params p{};
    p.x_in[0] = (const float*)d_in[0]; p.x_in[1] = (const float*)d_in[1];
    p.ffn1_norm = (const float*)d_in[2]; p.ffn1_w_in = (const float*)d_in[3]; p.ffn1_w_out = (const float*)d_in[4];
    p.mix_norm = (const float*)d_in[5]; p.ab_w_in = (const float*)d_in[6]; p.ab_q_norm = (const float*)d_in[7];
    p.ab_k_norm = (const float*)d_in[8]; p.ab_w_out = (const float*)d_in[9]; p.c_w_in = (const float*)d_in[10];
    p.c_gate_bias = (const float*)d_in[11]; p.c_conv = (const float*)d_in[12]; p.c_head_norm = (const float*)d_in[13];
    p.c_w_out = (const float*)d_in[14]; p.ffn2_norm = (const float*)d_in[15]; p.ffn2_w_in = (const float*)d_in[16];
    p.ffn2_w_out = (const float*)d_in[17];
    p.out = (float*)d_out; p.ws = (unsigned char*)d_ws;
    (void)hipMemsetAsync((unsigned char*)d_ws + WS_BAR, 0, 256, stream);
    void* args[] = {&p};
    hipError_t e = hipLaunchCooperativeKernel((const void*)mega, dim3(grid_blocks), dim3(512), args, LDS_BYTES, stream);
    if (e != hipSuccess) fprintf(stderr, "cooperative launch failed: %s (grid %d)\n", hipGetErrorString(e), grid_blocks);
}
```
